# Optimizing an MI355X kernel written in HIP

```python
import math
import jax, jax.numpy as jnp
from jax import lax
import numpy as np


D_MODEL = 1024
BATCH = 16
SEQ = 2048
DEPTH = 2

HEAD_DIM = 64
ROPE_THETA = 500000.0
ROT_DIM = HEAD_DIM // 4
NORM_EPS = 1e-6
Q_BLOCK = 128
NEG_INF = -1e30
N_NORMS = 7

A_HEADS = 4
A_QK_DIM = 64
A_V_DIM = 2 * A_QK_DIM
B_HEADS = 4
B_PATTERNS = ((128, 1), (512, 4), (2048, 16))
C_HEADS = 4
C_Q_RANK = 256
C_KV_RANK = 128
C_NOPE_DIM = 64
C_ROPE_DIM = 32
C_V_DIM = 64
MEM_LEN = 256
MEM_HEADS = 4
MEM_HEAD_DIM = 64
D_FF = -(-(8 * D_MODEL) // (3 * 256)) * 256

A_WIDTH = A_HEADS * A_V_DIM
B_WIDTH = B_HEADS * HEAD_DIM
C_WIDTH = C_HEADS * C_V_DIM
D_MIX = A_WIDTH + B_WIDTH + C_WIDTH
IN_SPLITS = (A_HEADS * 2 * A_QK_DIM, A_HEADS * 2 * A_QK_DIM, A_WIDTH,
             B_WIDTH, B_WIDTH, B_WIDTH, C_Q_RANK, C_KV_RANK, C_ROPE_DIM)
D_IN = sum(IN_SPLITS)

kernel_name = 'hybrid_parallel_head_encoder'


def rmsnorm(x, g):
    xf = x.astype(jnp.float32)
    y = xf * lax.rsqrt(jnp.mean(xf * xf, axis=-1, keepdims=True) + NORM_EPS)
    return (y * g.astype(jnp.float32)).astype(x.dtype)


def rope_tables(positions, dim):
    inv = ROPE_THETA ** (-jnp.arange(0, dim, 2, dtype=jnp.float32) / dim)
    ang = positions.astype(jnp.float32)[..., None] * inv
    return jnp.cos(ang), jnp.sin(ang)


def apply_rope(x, cos, sin):
    half = cos.shape[-1]
    shape = cos.shape[:2] + (1,) * (x.ndim - 3) + (half,)
    c = cos.reshape(shape).astype(x.dtype)
    s = sin.reshape(shape).astype(x.dtype)
    x1, x2 = x[..., :half], x[..., half:]
    return jnp.concatenate([x1 * c - x2 * s, x2 * c + x1 * s], axis=-1)


def partial_rope(x, cos, sin):
    rd = 2 * cos.shape[-1]
    return jnp.concatenate([apply_rope(x[..., :rd], cos, sin), x[..., rd:]], axis=-1)


def diff_attention(q, k, v, lam, subln_g, lam_init):
    B, S, H = q.shape[:3]
    nb = S // Q_BLOCK
    kh = k.transpose(0, 2, 3, 1, 4)
    vh = v.transpose(0, 2, 1, 3)
    qb = q.transpose(0, 2, 3, 1, 4).reshape(B, H, 2, nb, Q_BLOCK, A_QK_DIM)
    qb = qb.transpose(3, 0, 1, 2, 4, 5)
    scale = A_QK_DIM ** -0.5

    def block(q_blk):
        s = jnp.einsum('bhmqd,bhmkd->bhmqk', q_blk, kh).astype(jnp.float32) * scale
        p = jax.nn.softmax(s, axis=-1)
        w = p[:, :, 0] - lam * p[:, :, 1]
        return jnp.einsum('bhqk,bhkd->bhqd', w.astype(vh.dtype), vh)

    o = lax.map(block, qb)
    o = o.transpose(1, 0, 3, 2, 4).reshape(B, S, H, A_V_DIM)
    o = rmsnorm(o, subln_g) * (1.0 - lam_init)
    return o.reshape(B, S, H * A_V_DIM)


def dilated_branch(q, k, v, window, dilation):
    B, S, H, E = q.shape
    half = window // (2 * dilation)
    blk = half
    L = S // dilation
    Lp = -(-L // blk) * blk
    nb = Lp // blk

    def sub(t):
        return t.reshape(B, L, dilation, H, E).transpose(0, 2, 3, 1, 4)

    qs, ks, vs = sub(q), sub(k), sub(v)
    qb = jnp.pad(qs, ((0, 0), (0, 0), (0, 0), (0, Lp - L), (0, 0))).reshape(B, dilation, H, nb, blk, E)
    pad_kv = ((0, 0), (0, 0), (0, 0), (blk, Lp - L + blk), (0, 0))

    def band(t):
        tp = jnp.pad(t, pad_kv).reshape(B, dilation, H, nb + 2, blk, E)
        return jnp.concatenate([tp[:, :, :, 0:nb], tp[:, :, :, 1:nb + 1], tp[:, :, :, 2:nb + 2]], axis=4)

    kw, vw = band(ks), band(vs)
    jq = np.arange(nb)[:, None, None] * blk + np.arange(blk)[None, :, None]
    jk = (np.arange(nb)[:, None, None] - 1) * blk + np.arange(3 * blk)[None, None, :]
    valid = (np.abs(jq - jk) <= half) & (jk >= 0) & (jk < L)
    s = jnp.einsum('bdhnqe,bdhnke->bdhnqk', qb, kw).astype(jnp.float32) * (E ** -0.5)
    s = jnp.where(valid, s, NEG_INF)
    m = jnp.max(s, axis=-1, keepdims=True)
    e = jnp.exp(s - m)
    den = jnp.sum(e, axis=-1)
    o = jnp.einsum('bdhnqk,bdhnke->bdhnqe', e, vw.astype(jnp.float32)) / den[..., None]
    lse = m[..., 0] + jnp.log(den)
    o = o.reshape(B, dilation, H, Lp, E)[:, :, :, :L].transpose(0, 3, 1, 2, 4).reshape(B, S, H, E)
    lse = lse.reshape(B, dilation, H, Lp)[:, :, :, :L].transpose(0, 3, 1, 2).reshape(B, S, H)
    return o, lse


def dilated_attention(q, k, v):
    B, S, H, E = q.shape
    outs, lses = [], []
    for window, dilation in B_PATTERNS:
        o, lse = dilated_branch(q, k, v, window, dilation)
        outs.append(o)
        lses.append(lse)
    alpha = jax.nn.softmax(jnp.stack(lses, axis=0), axis=0)
    out = jnp.sum(alpha[..., None] * jnp.stack(outs, axis=0), axis=0)
    return out.astype(q.dtype).reshape(B, S, H * E)


def latent_attention(c_q, c_kv, k_rope, q_norm_g, kv_norm_g, w_q_up, w_kv_up, cos_c, sin_c):
    B, S, _ = c_q.shape
    nb = S // Q_BLOCK
    q = (rmsnorm(c_q, q_norm_g) @ w_q_up).reshape(B, S, C_HEADS, C_NOPE_DIM + C_ROPE_DIM)
    q_nope = q[..., :C_NOPE_DIM]
    q_rope = apply_rope(q[..., C_NOPE_DIM:], cos_c, sin_c)
    kv = (rmsnorm(c_kv, kv_norm_g) @ w_kv_up).reshape(B, S, C_HEADS, C_NOPE_DIM + C_V_DIM)
    kn = kv[..., :C_NOPE_DIM].transpose(0, 2, 1, 3)
    vh = kv[..., C_NOPE_DIM:].transpose(0, 2, 1, 3)
    kr = apply_rope(k_rope, cos_c, sin_c)
    qn = q_nope.transpose(0, 2, 1, 3).reshape(B, C_HEADS, nb, Q_BLOCK, C_NOPE_DIM).transpose(2, 0, 1, 3, 4)
    qr = q_rope.transpose(0, 2, 1, 3).reshape(B, C_HEADS, nb, Q_BLOCK, C_ROPE_DIM).transpose(2, 0, 1, 3, 4)
    scale = (C_NOPE_DIM + C_ROPE_DIM) ** -0.5

    def block(args):
        qn_b, qr_b = args
        s = (jnp.einsum('bhqd,bhkd->bhqk', qn_b, kn)
             + jnp.einsum('bhqr,bkr->bhqk', qr_b, kr)).astype(jnp.float32) * scale
        p = jax.nn.softmax(s, axis=-1)
        return jnp.einsum('bhqk,bhkd->bhqd', p.astype(vh.dtype), vh)

    o = lax.map(block, (qn, qr))
    return o.transpose(1, 0, 3, 2, 4).reshape(B, S, C_HEADS * C_V_DIM)


def memory_attention(h, mem_n, w_q, w_kv, w_o):
    B, S, _ = h.shape
    M = mem_n.shape[1]
    q = (h @ w_q).reshape(B, S, MEM_HEADS, MEM_HEAD_DIM)
    kv = (mem_n @ w_kv).reshape(B, M, 2, MEM_HEADS, MEM_HEAD_DIM)
    k, v = kv[:, :, 0], kv[:, :, 1]
    s = jnp.einsum('bqhd,bkhd->bhqk', q, k).astype(jnp.float32) * (MEM_HEAD_DIM ** -0.5)
    p = jax.nn.softmax(s, axis=-1)
    o = jnp.einsum('bhqk,bkhd->bqhd', p.astype(v.dtype), v).reshape(B, S, MEM_HEADS * MEM_HEAD_DIM)
    return o @ w_o


def setup_inputs(seed: int = 0) -> dict:
    key = jax.random.key(seed)
    ks = jax.random.split(key, 20)
    f32 = jnp.float32

    def nrm(k, shape, fan_in):
        return jax.random.normal(k, shape, f32) * (fan_in ** -0.5)

    def gain(k, shape):
        return 1.0 + 0.05 * jax.random.normal(k, shape, f32)

    x = jax.random.normal(ks[0], (BATCH, SEQ, D_MODEL), f32)
    mem = jax.random.normal(ks[1], (BATCH, MEM_LEN, D_MODEL), f32)
    offsets = jax.random.randint(ks[2], (BATCH, 1), 0, 4096, dtype=jnp.int32)
    positions = (offsets + jnp.arange(SEQ, dtype=jnp.int32)[None, :]).astype(jnp.int32)
    return {
        'x': x,
        'mem': mem,
        'positions': positions,
        'norm_gains': gain(ks[3], (DEPTH, N_NORMS, D_MODEL)),
        'w_in': nrm(ks[4], (DEPTH, D_MODEL, D_IN), D_MODEL),
        'w_out': nrm(ks[5], (DEPTH, D_MIX, D_MODEL), D_MIX),
        'diff_lambda': 0.1 * jax.random.normal(ks[6], (DEPTH, 4, A_QK_DIM), f32),
        'diff_subln': gain(ks[7], (DEPTH, A_V_DIM)),
        'mla_q_norm': gain(ks[8], (DEPTH, C_Q_RANK)),
        'mla_kv_norm': gain(ks[9], (DEPTH, C_KV_RANK)),
        'w_mla_q_up': nrm(ks[10], (DEPTH, C_Q_RANK, C_HEADS * (C_NOPE_DIM + C_ROPE_DIM)), C_Q_RANK),
        'w_mla_kv_up': nrm(ks[11], (DEPTH, C_KV_RANK, C_HEADS * (C_NOPE_DIM + C_V_DIM)), C_KV_RANK),
        'w_mem_q': nrm(ks[12], (DEPTH, D_MODEL, MEM_HEADS * MEM_HEAD_DIM), D_MODEL),
        'w_mem_kv': nrm(ks[13], (DEPTH, D_MODEL, 2 * MEM_HEADS * MEM_HEAD_DIM), D_MODEL),
        'w_mem_o': nrm(ks[14], (DEPTH, MEM_HEADS * MEM_HEAD_DIM, D_MODEL), MEM_HEADS * MEM_HEAD_DIM),
        'w_ffn_gate': nrm(ks[15], (DEPTH, D_MODEL, D_FF), D_MODEL),
        'w_ffn_up': nrm(ks[16], (DEPTH, D_MODEL, D_FF), D_MODEL),
        'w_ffn_down': nrm(ks[17], (DEPTH, D_FF, D_MODEL), D_FF),
    }


def reference(x, mem, positions, norm_gains, w_in, w_out, diff_lambda, diff_subln,
              mla_q_norm, mla_kv_norm, w_mla_q_up, w_mla_kv_up, w_mem_q, w_mem_kv,
              w_mem_o, w_ffn_gate, w_ffn_up, w_ffn_down):
    B, S, _ = x.shape
    cos_p, sin_p = rope_tables(positions, ROT_DIM)
    cos_c, sin_c = rope_tables(positions, C_ROPE_DIM)
    split_points = np.cumsum(IN_SPLITS)[:-1].tolist()
    for l in range(DEPTH):
        g = norm_gains[l]
        h = rmsnorm(x, g[0])
        qa, ka, va, qb, kb, vb, cq, ckv, kr = jnp.split(h @ w_in[l], split_points, axis=-1)
        lam_init = 0.8 - 0.6 * math.exp(-0.3 * l)
        lv = diff_lambda[l].astype(jnp.float32)
        lam = jnp.exp(jnp.sum(lv[0] * lv[1])) - jnp.exp(jnp.sum(lv[2] * lv[3])) + lam_init
        qa = partial_rope(qa.reshape(B, S, A_HEADS, 2, A_QK_DIM), cos_p, sin_p)
        ka = partial_rope(ka.reshape(B, S, A_HEADS, 2, A_QK_DIM), cos_p, sin_p)
        oa = diff_attention(qa, ka, va.reshape(B, S, A_HEADS, A_V_DIM), lam, diff_subln[l], lam_init)
        qb = partial_rope(qb.reshape(B, S, B_HEADS, HEAD_DIM), cos_p, sin_p)
        kb = partial_rope(kb.reshape(B, S, B_HEADS, HEAD_DIM), cos_p, sin_p)
        ob = dilated_attention(qb, kb, vb.reshape(B, S, B_HEADS, HEAD_DIM))
        oc = latent_attention(cq, ckv, kr, mla_q_norm[l], mla_kv_norm[l],
                              w_mla_q_up[l], w_mla_kv_up[l], cos_c, sin_c)
        mixed = jnp.concatenate([oa, ob, oc], axis=-1) @ w_out[l]
        x = x + rmsnorm(mixed, g[1])
        h = rmsnorm(x, g[2])
        mem_n = rmsnorm(mem, g[3])
        x = x + rmsnorm(memory_attention(h, mem_n, w_mem_q[l], w_mem_kv[l], w_mem_o[l]), g[4])
        h = rmsnorm(x, g[5])
        f = (jax.nn.silu(h @ w_ffn_gate[l]) * (h @ w_ffn_up[l])) @ w_ffn_down[l]
        x = x + rmsnorm(f, g[6])
    return x
```

```cpp
#include <hip/hip_runtime.h>
#include <hip/hip_cooperative_groups.h>
#include <cstdio>
#include <cstdint>
namespace cg = cooperative_groups;

#define LAS __attribute__((address_space(3)))
constexpr int NWAVES = 8;
constexpr int LDS_BYTES = 147456;
constexpr int BATCH = 16, SEQ = 2048, DM = 1024, MTOK = BATCH * SEQ, DEPTH = 2;
constexpr int DIN = 2720, QKV_LD = 2816, DFF = 2816, MEML = 256, MEMTOK = BATCH * MEML;
constexpr float NORM_EPS = 1e-6f;
constexpr float LOG2E = 1.4426950408889634f;

#define XB_TMO      128
#define XB_XCNT(j)  (256  + 64 * (j))
#define XB_XSUB(j)  (1280 + 64 * (j))
#define XB_XGEN(j)  (2304 + 64 * (j))
#define XB_TOP      3328
#define XB_TOPGEN   3392
#define XCD_BAR_WORDS 3456
#define XB_SPIN_CAP (1u << 18)
__device__ __forceinline__ unsigned xb_ld(unsigned* p)              { return __hip_atomic_load(p, __ATOMIC_RELAXED, __HIP_MEMORY_SCOPE_AGENT); }
__device__ __forceinline__ unsigned xb_add(unsigned* p, unsigned v) { return __hip_atomic_fetch_add(p, v, __ATOMIC_RELAXED, __HIP_MEMORY_SCOPE_AGENT); }
__device__ __forceinline__ unsigned xb_xcc_id() { return (unsigned)__builtin_amdgcn_s_getreg((3 << 11) | 20) & 0xFu; }
#define XB_SPIN(cond, bar) do { unsigned _sp = 0; while (cond) { __builtin_amdgcn_s_sleep(1); \
    if ((++_sp & 255u) == 0u) { if (xb_ld(&(bar)[XB_TMO])) break; if (_sp > XB_SPIN_CAP) { atomicAdd(&(bar)[XB_TMO], 1u); break; } } } } while (0)
struct XcdBarrier { unsigned* bar; unsigned x; volatile LAS unsigned* st; };
__device__ __forceinline__ XcdBarrier xcd_barrier_post(unsigned* bar, volatile LAS unsigned* st) {
    XcdBarrier b; b.bar = bar; b.x = xb_xcc_id(); b.st = st;
    if (threadIdx.x == 0) (void)xb_add(&bar[XB_XCNT(b.x)], 1u);
    return b;
}
__device__ __forceinline__ void xcd_barrier_complete(unsigned* bar, unsigned x, unsigned& nloc, unsigned& nx) {
    const unsigned G = gridDim.x * gridDim.y * gridDim.z;
    unsigned sum, cnt, mine, sp = 0u;
    for (;;) {
        sum = 0u; cnt = 0u; mine = 0u;
#pragma unroll
        for (unsigned j = 0; j < 16; ++j) { const unsigned c = xb_ld(&bar[XB_XCNT(j)]); sum += c; cnt += (c > 0u) ? 1u : 0u; mine = (j == x) ? c : mine; }
        if (sum == G) break;
        __builtin_amdgcn_s_sleep(1);
        if ((++sp & 255u) == 0u) { if (xb_ld(&bar[XB_TMO])) break; if (sp > XB_SPIN_CAP) { atomicAdd(&bar[XB_TMO], 1u); break; } }
    }
    nloc = mine > 0u ? mine : 1u; nx = cnt > 0u ? cnt : 1u;
}
__device__ __forceinline__ void xcd_barrier(const XcdBarrier& b) {
    asm volatile("s_waitcnt vmcnt(0)" ::: "memory");
    __syncthreads();
    if (threadIdx.x == 0) {
        unsigned* bar = b.bar;
        __builtin_amdgcn_s_waitcnt(0);
        unsigned nloc = b.st[0], nx = b.st[1];
        if (nloc == 0u) { xcd_barrier_complete(bar, b.x, nloc, nx); b.st[0] = nloc; b.st[1] = nx; }
        const unsigned old = xb_add(&bar[XB_XSUB(b.x)], 1u);
        const unsigned gen = old / nloc;
        if (old + 1u == (gen + 1u) * nloc) {
            __builtin_amdgcn_fence(__ATOMIC_RELEASE, "agent");
            asm volatile("s_waitcnt vmcnt(0)" ::: "memory");
            const unsigned og = xb_add(&bar[XB_TOP], 1u);
            const unsigned tg = og / nx;
            if (og + 1u == (tg + 1u) * nx) xb_add(&bar[XB_TOPGEN], 1u);
            else XB_SPIN(xb_ld(&bar[XB_TOPGEN]) == tg, bar);
            __builtin_amdgcn_fence(__ATOMIC_ACQUIRE, "agent");
            xb_add(&bar[XB_XGEN(b.x)], 1u);
            asm volatile("s_waitcnt vmcnt(0)" ::: "memory");
        } else {
            XB_SPIN(xb_ld(&bar[XB_XGEN(b.x)]) == gen, bar);
            __builtin_amdgcn_fence(__ATOMIC_ACQUIRE, "agent");
            asm volatile("s_waitcnt vmcnt(0)" ::: "memory");
        }
    }
    __syncthreads();
}

namespace pg8 {
#define PG8_LAS __attribute__((address_space(3)))
typedef unsigned short bf16_t;
typedef short bf16x8 __attribute__((ext_vector_type(8)));
typedef float f32x4 __attribute__((ext_vector_type(4)));
typedef unsigned u32x4 __attribute__((ext_vector_type(4)));
constexpr int BM = 256, BK = 64, HALF = 128, HTB = HALF * BK * 2  , STAGE_BYTES = 8 * HTB, NXCD = 8, WGM = 8;

__host__ __device__ __forceinline__ int lds_byte(int r, int c) { const int st = (r >> 4) * 2 + (c >> 5), rr = r & 15, cc = c & 31, ob = rr * 64 + cc * 2; return st * 1024 + (ob ^ (((ob >> 9) & 1) << 5)); }
__host__ __device__ __forceinline__ void stage_rc(int b, int& R, int& C) { const int st = b / 1024, sb = b % 1024, swz = sb ^ (((sb >> 9) & 1) << 5); R = (st >> 1) * 16 + swz / 64; C = (st & 1) * 32 + (swz % 64) / 2; }
__host__ __device__ __forceinline__ int perm32(int rho) { const int n = rho >> 4, i = rho & 15; return 8 * (i >> 2) + 4 * n + (i & 3); }

struct Unit { int pm, pn; };
struct Gemm { const bf16_t* A; const bf16_t* Bt; int M, N, K, lda; };

struct StaticOrder {
    int nM, nN, nwg, G, c;
    __host__ __device__ void init(int M, int N, int G_, int c_) { nM = M / BM; nN = N / BM; nwg = nM * nN; G = G_; c = c_; }
    __host__ __device__ bool next(int i, Unit& u) const {
        const long L = (long)i * G + c; if (L >= nwg) return false;
        int wgid = (int)L; { const int q = nwg / NXCD, r = nwg % NXCD, xcd = wgid % NXCD, off = wgid / NXCD; wgid = (xcd < r ? xcd * (q + 1) : r * (q + 1) + (xcd - r) * q) + off; }
        const int nig = WGM * nN, gid = wgid / nig, fm = gid * WGM, gsz = (nM - fm) < WGM ? (nM - fm) : WGM;
        u.pm = fm + ((wgid % nig) % gsz); u.pn = (wgid % nig) / gsz; return true;
    }
    __device__ __forceinline__ void a_ready(const Unit&) const {}
    __device__ __forceinline__ void done(const Unit&) const {}
};

template <class Epi, class Sched, bool ALIGN_EPI = false, bool SP2 = false>
__device__ __forceinline__ void gemm_phase(PG8_LAS unsigned char* lds, const Gemm g, const Sched& S, const Epi& E) {
    int tid_ = threadIdx.x; asm volatile("" : "+v"(tid_));
    const int tid = tid_, wid = __builtin_amdgcn_readfirstlane(tid >> 6), lane = tid & 63, wr = wid >> 2, wc = wid & 3, fr = lane & 15, fq = lane >> 4;
    const int K = g.K, nt = K / BK;
    unsigned voffA[2], voffB[2];
#pragma unroll
    for (int i = 0; i < 2; ++i) { int R, C; stage_rc(tid * 16 + i * 8192, R, C); const int Rb = Epi::PERM ? ((R & ~31) + perm32(R & 31)) : R;
        voffA[i] = (unsigned)(R * g.lda + C) * 2u; voffB[i] = (unsigned)(Rb * K + C) * 2u; }
    const size_t kstep = (size_t)(BK * 2);
    const size_t hstepA = (size_t)HALF * g.lda * 2, hstepB = (size_t)HALF * K * 2;
    const size_t tstepA = 2 * hstepA, tstepB = 2 * hstepB;
    const unsigned ldsw = (unsigned)wid * 1024u;
    const int aoff = lds_byte(wr * 64 + fr, fq * 8), boff = lds_byte(wc * 32 + fr, fq * 8);
#define PG8_SA(b, h) (((b) * 2 + (h)) * HTB)
#define PG8_SB(b, h) ((4 + (b) * 2 + (h)) * HTB)
#define PG8_STAGE(bufoff, gbase, voff) do { _Pragma("unroll") for (int _i = 0; _i < 2; ++_i) \
        __builtin_amdgcn_global_load_lds((const unsigned*)((const char*)(gbase) + (voff)[_i]), (PG8_LAS unsigned*)(lds + (bufoff) + ldsw + _i * 8192), 16, 0, 0); } while (0)
#define PG8_LDA(dst, b, h) do { _Pragma("unroll") for (int m = 0; m < 4; ++m) _Pragma("unroll") for (int k = 0; k < 2; ++k) dst[m][k] = *(const PG8_LAS bf16x8*)(lds + PG8_SA(b, h) + aoff + m * 2048 + k * 1024); } while (0)
#define PG8_LDB(dst, b, h) do { _Pragma("unroll") for (int n = 0; n < 2; ++n) _Pragma("unroll") for (int k = 0; k < 2; ++k) dst[n][k] = *(const PG8_LAS bf16x8*)(lds + PG8_SB(b, h) + boff + n * 2048 + k * 1024); } while (0)
#define PG8_MMA(ai, bj, At, Bt) do { __builtin_amdgcn_s_setprio(1); _Pragma("unroll") for (int m = 0; m < 4; ++m) _Pragma("unroll") for (int n = 0; n < 2; ++n) _Pragma("unroll") for (int k = 0; k < 2; ++k) \
        acc[ai][bj][m][n] = __builtin_amdgcn_mfma_f32_16x16x32_bf16(Bt[n][k], At[m][k], acc[ai][bj][m][n], 0, 0, 0); __builtin_amdgcn_s_setprio(0); } while (0)
#define PG8_WAIT_V(n) asm volatile("s_waitcnt vmcnt(" #n ")" ::: "memory")
#define PG8_WAIT_L(n) asm volatile("s_waitcnt lgkmcnt(" #n ")" ::: "memory")
#define PG8_BAR __builtin_amdgcn_s_barrier()
#define PG8_SCHED __builtin_amdgcn_sched_barrier(0)
    Unit cur, nxt; int ui = 0;
    if (!S.next(0, cur)) return;
    f32x4 acc[2][2][4][2];
#pragma unroll
    for (int a = 0; a < 2; ++a)
#pragma unroll
        for (int b = 0; b < 2; ++b)
#pragma unroll
            for (int m = 0; m < 4; ++m)
#pragma unroll
                for (int n = 0; n < 2; ++n) acc[a][b][m][n] = (f32x4){0.f, 0.f, 0.f, 0.f};
    bf16x8 At[4][2], B0[2][2], B1[2][2];
    const char* cA = (const char*)g.A + (size_t)cur.pm * tstepA; const char* cB = (const char*)g.Bt + (size_t)cur.pn * tstepB;
    S.a_ready(cur);
    if constexpr (SP2) {
        PG8_STAGE(PG8_SB(0, 0), cB, voffB); PG8_STAGE(PG8_SB(0, 1), cB + hstepB, voffB); PG8_STAGE(PG8_SA(0, 0), cA, voffA); PG8_STAGE(PG8_SA(0, 1), cA + hstepA, voffA);
        if (wr == 1) PG8_BAR;
        PG8_WAIT_V(2); PG8_BAR;
        PG8_STAGE(PG8_SB(1, 0), cB + kstep, voffB); PG8_STAGE(PG8_SA(1, 0), cA + kstep, voffA); PG8_STAGE(PG8_SB(1, 1), cB + hstepB + kstep, voffB);
        PG8_WAIT_V(6); PG8_BAR;
    } else {
        PG8_STAGE(PG8_SB(0, 0), cB, voffB); PG8_STAGE(PG8_SA(0, 0), cA, voffA); PG8_STAGE(PG8_SB(0, 1), cB + hstepB, voffB); PG8_STAGE(PG8_SA(0, 1), cA + hstepA, voffA);
        if (wr == 1) PG8_BAR;
        PG8_WAIT_V(4); PG8_BAR;
        PG8_STAGE(PG8_SB(1, 0), cB + kstep, voffB); PG8_STAGE(PG8_SA(1, 0), cA + kstep, voffA); PG8_STAGE(PG8_SB(1, 1), cB + hstepB + kstep, voffB);
        PG8_WAIT_V(6); PG8_BAR;
    }
    for (;;) {
        const bool has_next = S.next(ui + 1, nxt);
        const char* nA = has_next ? (const char*)g.A + (size_t)nxt.pm * tstepA : cA; const char* nB = has_next ? (const char*)g.Bt + (size_t)nxt.pn * tstepB : cB;
        for (int t = 0; t < nt; t += 2) {
            const bool last = (t == nt - 2);
            const char* a1 = cA + (size_t)(t + 1) * kstep;
            const char* a2 = last ? nA : cA + (size_t)(t + 2) * kstep; const char* b2 = last ? nB : cB + (size_t)(t + 2) * kstep;
            const char* a3 = a2 + kstep; const char* b3 = b2 + kstep;
            if (last && has_next) S.a_ready(nxt);
            if constexpr (SP2) {
            PG8_LDB(B0, 0, 0); PG8_LDB(B1, 0, 1); PG8_SCHED; PG8_LDA(At, 0, 0); PG8_STAGE(PG8_SA(1, 1), a1 + hstepA, voffA);
            PG8_WAIT_V(8); PG8_WAIT_L(0); PG8_BAR; PG8_MMA(0, 0, At, B0); PG8_MMA(0, 1, At, B1); PG8_BAR; PG8_SCHED;
            PG8_LDA(At, 0, 1); PG8_STAGE(PG8_SB(0, 0), b2, voffB); PG8_STAGE(PG8_SB(0, 1), b2 + hstepB, voffB); PG8_STAGE(PG8_SA(0, 0), a2, voffA);
            PG8_WAIT_V(8); PG8_WAIT_L(0); PG8_BAR; PG8_MMA(1, 0, At, B0); PG8_MMA(1, 1, At, B1); PG8_BAR; PG8_SCHED;
            PG8_LDB(B0, 1, 0); PG8_LDB(B1, 1, 1); PG8_SCHED; PG8_LDA(At, 1, 0); PG8_STAGE(PG8_SA(0, 1), a2 + hstepA, voffA);
            PG8_WAIT_V(8); PG8_WAIT_L(0); PG8_BAR; PG8_MMA(0, 0, At, B0); PG8_MMA(0, 1, At, B1); PG8_BAR; PG8_SCHED;
            PG8_LDA(At, 1, 1); PG8_STAGE(PG8_SB(1, 0), b3, voffB); PG8_STAGE(PG8_SB(1, 1), b3 + hstepB, voffB); PG8_STAGE(PG8_SA(1, 0), a3, voffA);
            PG8_WAIT_V(8); PG8_WAIT_L(0); PG8_BAR; PG8_MMA(1, 0, At, B0); PG8_MMA(1, 1, At, B1); PG8_BAR; PG8_SCHED;
            } else {
            PG8_LDB(B0, 0, 0); PG8_SCHED; PG8_LDA(At, 0, 0); PG8_STAGE(PG8_SA(1, 1), a1 + hstepA, voffA);
            PG8_WAIT_L(8); PG8_BAR; PG8_WAIT_L(0); PG8_MMA(0, 0, At, B0); PG8_BAR; PG8_SCHED;
            PG8_LDB(B1, 0, 1); PG8_STAGE(PG8_SB(0, 0), b2, voffB);
            PG8_BAR; PG8_WAIT_L(0); PG8_MMA(0, 1, At, B1); PG8_BAR;
            PG8_LDA(At, 0, 1); PG8_STAGE(PG8_SA(0, 0), a2, voffA);
            PG8_BAR; PG8_WAIT_L(0); PG8_MMA(1, 0, At, B0); PG8_BAR; PG8_SCHED;
            PG8_STAGE(PG8_SB(0, 1), b2 + hstepB, voffB);
            PG8_WAIT_V(6); PG8_BAR; PG8_MMA(1, 1, At, B1); PG8_BAR;
            PG8_LDB(B0, 1, 0); PG8_SCHED; PG8_LDA(At, 1, 0); PG8_STAGE(PG8_SA(0, 1), a2 + hstepA, voffA);
            PG8_WAIT_L(8); PG8_BAR; PG8_WAIT_L(0); PG8_MMA(0, 0, At, B0); PG8_BAR; PG8_SCHED;
            PG8_LDB(B1, 1, 1); PG8_STAGE(PG8_SB(1, 0), b3, voffB);
            PG8_BAR; PG8_WAIT_L(0); PG8_MMA(0, 1, At, B1); PG8_BAR;
            PG8_LDA(At, 1, 1); PG8_STAGE(PG8_SA(1, 0), a3, voffA);
            PG8_BAR; PG8_WAIT_L(0); PG8_MMA(1, 0, At, B0); PG8_BAR; PG8_SCHED;
            PG8_STAGE(PG8_SB(1, 1), b3 + hstepB, voffB);
            PG8_WAIT_V(6); PG8_BAR; PG8_MMA(1, 1, At, B1); PG8_BAR;
            }
        }
        if constexpr (ALIGN_EPI) { if (wr == 0) PG8_BAR; }
        if constexpr (!Epi::AFTER_DRAIN) { E(acc, cur, wr, wc, fr, fq); S.done(cur); }
        if (!has_next) break;
#pragma unroll
        for (int a = 0; a < 2; ++a)
#pragma unroll
            for (int b = 0; b < 2; ++b)
#pragma unroll
                for (int m = 0; m < 4; ++m)
#pragma unroll
                    for (int n = 0; n < 2; ++n) acc[a][b][m][n] = (f32x4){0.f, 0.f, 0.f, 0.f};
        cur = nxt; cA = nA; cB = nB; ++ui;
        if constexpr (ALIGN_EPI) { if (wr == 1) PG8_BAR; }
    }
    PG8_WAIT_V(0);
    if constexpr (!ALIGN_EPI) { if (wr == 0) PG8_BAR; }
    PG8_BAR;
    if constexpr (Epi::AFTER_DRAIN) { E.fused(acc, cur, wr, wc, fr, fq, lds, wid, lane); S.done(cur); }
#undef PG8_SA
#undef PG8_SB
#undef PG8_STAGE
#undef PG8_LDA
#undef PG8_LDB
#undef PG8_MMA
#undef PG8_WAIT_V
#undef PG8_WAIT_L
#undef PG8_BAR
#undef PG8_SCHED
}
}

namespace pg8 {
__device__ __forceinline__ unsigned cvt_pk_bf16(float lo, float hi) { unsigned r; asm volatile("v_cvt_pk_bf16_f32 %0, %1, %2" : "=v"(r) : "v"(lo), "v"(hi)); return r; }
__device__ __forceinline__ void store8(bf16_t* p, const f32x4 v0, const f32x4 v1) {
    u32x4 w; w.x = cvt_pk_bf16(v0[0], v0[1]); w.y = cvt_pk_bf16(v0[2], v0[3]); w.z = cvt_pk_bf16(v1[0], v1[1]); w.w = cvt_pk_bf16(v1[2], v1[3]);
    *(u32x4*)p = w;
}
__device__ __forceinline__ void rot4(f32x4& a, f32x4& b, const f32x4 c, const f32x4 s) {
    const f32x4 x1 = a, x2 = b; a = x1 * c - x2 * s; b = x2 * c + x1 * s;
}
struct EpiPlain {
    static constexpr bool PERM = true, AFTER_DRAIN = false;
    bf16_t* O; int ldc;
    __device__ __forceinline__ void operator()(const f32x4 (&acc)[2][2][4][2], const Unit& u, int wr, int wc, int fr, int fq) const {
        const int row0 = u.pm * BM + wr * 64 + fr, col0 = u.pn * BM + wc * 32 + 8 * fq;
#pragma unroll
        for (int ai = 0; ai < 2; ++ai)
#pragma unroll
            for (int m = 0; m < 4; ++m) { bf16_t* rowp = O + (size_t)(row0 + ai * HALF + m * 16) * ldc + col0;
#pragma unroll
                for (int bj = 0; bj < 2; ++bj) store8(rowp + bj * HALF, acc[ai][bj][m][0], acc[ai][bj][m][1]); }
    }
};
struct EpiQKV {
    static constexpr bool PERM = true, AFTER_DRAIN = false;
    bf16_t* O; const float* ropeP; const float* ropeC; float* cqssq; float* ckvssq;
    __device__ __forceinline__ void operator()(const f32x4 (&acc)[2][2][4][2], const Unit& u, int wr, int wc, int fr, int fq) const {
        const int pn = u.pn;
        const int row0 = u.pm * BM + wr * 64 + fr, col0 = pn * BM + wc * 32 + 8 * fq;
        const bool rope64 = ((pn < 4) || pn == 6 || pn == 7) && !(wc & 1) && (fq < 2);
        const bool ropekr = (pn == 10) && (wc == 0);
#pragma unroll
        for (int ai = 0; ai < 2; ++ai)
#pragma unroll
            for (int m = 0; m < 4; ++m) {
                const int row = row0 + ai * HALF + m * 16;
                f32x4 v[2][2];
#pragma unroll
                for (int bj = 0; bj < 2; ++bj) { v[bj][0] = acc[ai][bj][m][0]; v[bj][1] = acc[ai][bj][m][1]; }
                if (rope64) {
                    const f32x4 c = *(const f32x4*)(ropeP + (size_t)row * 16 + fq * 4), s = *(const f32x4*)(ropeP + (size_t)row * 16 + 8 + fq * 4);
                    rot4(v[0][0], v[0][1], c, s); rot4(v[1][0], v[1][1], c, s);
                }
                if (ropekr) {
                    const f32x4 c = *(const f32x4*)(ropeC + (size_t)row * 32 + fq * 4), s = *(const f32x4*)(ropeC + (size_t)row * 32 + 16 + fq * 4);
                    rot4(v[1][0], v[1][1], c, s);
                }
                if (pn == 9 || pn == 10) {
                    float ss = 0.f;
#pragma unroll
                    for (int e = 0; e < 4; ++e) ss += v[0][0][e] * v[0][0][e] + v[0][1][e] * v[0][1][e];
                    if (pn == 9) {
#pragma unroll
                        for (int e = 0; e < 4; ++e) ss += v[1][0][e] * v[1][0][e] + v[1][1][e] * v[1][1][e];
                    }
                    ss += __shfl_xor(ss, 16); ss += __shfl_xor(ss, 32);
                    if (fq == 0) { float* dst = (pn == 9) ? cqssq : ckvssq; dst[(size_t)row * 4 + wc] = ss; }
                }
                bf16_t* rowp = O + (size_t)row * QKV_LD + col0;
                store8(rowp, v[0][0], v[0][1]); store8(rowp + HALF, v[1][0], v[1][1]);
                asm volatile("" ::: "memory");
            }
    }
};
template <bool ROPE, int NCOLS> struct EpiMLA {
    static constexpr bool PERM = true, AFTER_DRAIN = false;
    bf16_t* O; const float* ssq; const float* ropeC;
    __device__ __forceinline__ void operator()(const f32x4 (&acc)[2][2][4][2], const Unit& u, int wr, int wc, int fr, int fq) const {
        const int row0 = u.pm * BM + wr * 64 + fr, col0 = u.pn * BM + wc * 32 + 8 * fq;
#pragma unroll
        for (int ai = 0; ai < 2; ++ai)
#pragma unroll
            for (int m = 0; m < 4; ++m) {
                const int row = row0 + ai * HALF + m * 16;
                const f32x4 p = *(const f32x4*)(ssq + (size_t)row * 4);
                const float rstd = __builtin_amdgcn_rsqf(((p[0] + p[1]) + (p[2] + p[3])) * (1.0f / NCOLS) + NORM_EPS);
#pragma unroll
                for (int bj = 0; bj < 2; ++bj) {
                    const int c0 = col0 + bj * HALF;
                    f32x4 v0 = acc[ai][bj][m][0] * rstd, v1 = acc[ai][bj][m][1] * rstd;
                    if (ROPE) { const int w = c0 % 96;
                        if (c0 < 384 && w >= 64) { const int f = (w - 64) >> 3;
                            const f32x4 c = *(const f32x4*)(ropeC + (size_t)row * 32 + f * 4), s = *(const f32x4*)(ropeC + (size_t)row * 32 + 16 + f * 4);
                            rot4(v0, v1, c, s); } }
                    store8(O + (size_t)row * 512 + c0, v0, v1);
                }
                asm volatile("" ::: "memory");
            }
    }
};
struct EpiSwiGLU {
    static constexpr bool PERM = true, AFTER_DRAIN = false;
    bf16_t* O;
    __device__ __forceinline__ void operator()(const f32x4 (&acc)[2][2][4][2], const Unit& u, int wr, int wc, int fr, int fq) const {
        const int row0 = u.pm * BM + wr * 64 + fr, col0 = u.pn * HALF + wc * 32 + 8 * fq;
#pragma unroll
        for (int ai = 0; ai < 2; ++ai)
#pragma unroll
            for (int m = 0; m < 4; ++m) {
                f32x4 hh[2];
#pragma unroll
                for (int n = 0; n < 2; ++n) { const f32x4 g = acc[ai][0][m][n], uu = acc[ai][1][m][n];
#pragma unroll
                    for (int e = 0; e < 4; ++e) hh[n][e] = g[e] * uu[e] * __builtin_amdgcn_rcpf(1.0f + __builtin_amdgcn_exp2f(-g[e] * LOG2E)); }
                store8(O + (size_t)(row0 + ai * HALF + m * 16) * DFF + col0, hh[0], hh[1]);
            }
    }
};
}

typedef unsigned short bf16_t;
namespace att {
using bf16x8 = __attribute__((ext_vector_type(8))) short;
using s16x4  = __attribute__((ext_vector_type(4))) short;
using f32x16 = __attribute__((ext_vector_type(16))) float;
using u32x4  = __attribute__((ext_vector_type(4))) unsigned;
#define SBAR() __builtin_amdgcn_sched_barrier(0)
__device__ __forceinline__ int crow(int r, int hi) { return (r & 3) + 8 * (r >> 2) + 4 * hi; }
__device__ __forceinline__ unsigned cvtpk(float lo, float hi) { unsigned r; asm volatile("v_cvt_pk_bf16_f32 %0, %1, %2" : "=v"(r) : "v"(lo), "v"(hi)); return r; }
__device__ __forceinline__ unsigned short f2bf(float f) { unsigned u = __builtin_bit_cast(unsigned, f); return (unsigned short)((u + 0x7fffu + ((u >> 16) & 1u)) >> 16); }
__device__ __forceinline__ int ka_off(int row, int c) { return row * 128 + ((c ^ ((row >> 1) & 7)) << 4); }
__device__ __forceinline__ int kb_off(int row, int c) { return row * 64 + ((c ^ ((row >> 2) & 3)) << 4); }
template <int NCB> __device__ __forceinline__ int v_st(int k, int c) { const int kk = (k & ~0xC) | ((k & 4) << 1) | ((k & 8) >> 1); return ((kk >> 3) * NCB + (c >> 5)) * 512 + ((kk & 7) * 32 + (c & 31)) * 2; }
__device__ __forceinline__ int v_rd_base(int lane) { return ((lane & 3) << 3) | (((lane >> 2) & 3) << 6) | (((lane >> 4) & 1) << 5) | (((lane >> 5) & 1) << 8); }
template <int NCB> constexpr int v_rd_off(int d0, int ks, int half) { return d0 * 512 + ks * (2 * NCB * 512) + half * (NCB * 512); }
template <int OFF> __device__ __forceinline__ s16x4 tr_read(unsigned vb) {
    s16x4 r; asm volatile("ds_read_b64_tr_b16 %0, %1 offset:%2" : "=&v"(r) : "v"(vb), "i"(OFF) : "memory"); return r;
}
template <int D0, int NCB> __device__ __forceinline__ void pv_one(f32x16& od, unsigned vb, bf16x8 pa0, bf16x8 pa1, bf16x8 pa2, bf16x8 pa3) {
    const s16x4 l0 = tr_read<v_rd_off<NCB>(D0, 0, 0)>(vb), h0 = tr_read<v_rd_off<NCB>(D0, 0, 1)>(vb), l1 = tr_read<v_rd_off<NCB>(D0, 1, 0)>(vb), h1 = tr_read<v_rd_off<NCB>(D0, 1, 1)>(vb);
    const s16x4 l2 = tr_read<v_rd_off<NCB>(D0, 2, 0)>(vb), h2 = tr_read<v_rd_off<NCB>(D0, 2, 1)>(vb), l3 = tr_read<v_rd_off<NCB>(D0, 3, 0)>(vb), h3 = tr_read<v_rd_off<NCB>(D0, 3, 1)>(vb);
    asm volatile("s_waitcnt lgkmcnt(0)" ::: "memory"); SBAR();
#define ATT_PK(L, H) (bf16x8){L[0], L[1], L[2], L[3], H[0], H[1], H[2], H[3]}
    od = __builtin_amdgcn_mfma_f32_32x32x16_bf16(pa0, ATT_PK(l0, h0), od, 0, 0, 0);
    od = __builtin_amdgcn_mfma_f32_32x32x16_bf16(pa1, ATT_PK(l1, h1), od, 0, 0, 0);
    od = __builtin_amdgcn_mfma_f32_32x32x16_bf16(pa2, ATT_PK(l2, h2), od, 0, 0, 0);
    od = __builtin_amdgcn_mfma_f32_32x32x16_bf16(pa3, ATT_PK(l3, h3), od, 0, 0, 0);
#undef ATT_PK
}
template <int NCB> __device__ __forceinline__ void pv_all(f32x16* o, unsigned vb, bf16x8 pa0, bf16x8 pa1, bf16x8 pa2, bf16x8 pa3) {
    pv_one<0, NCB>(o[0], vb, pa0, pa1, pa2, pa3); pv_one<1, NCB>(o[1], vb, pa0, pa1, pa2, pa3);
    if constexpr (NCB == 4) { pv_one<2, NCB>(o[2], vb, pa0, pa1, pa2, pa3); pv_one<3, NCB>(o[3], vb, pa0, pa1, pa2, pa3); }
}
constexpr float THR = 8.f;
__device__ __forceinline__ float rowmax32(const f32x16& p0, const f32x16& p1) {
    float pmax = p0[0];
#pragma unroll
    for (int r = 1; r < 16; ++r) pmax = fmaxf(pmax, p0[r]);
#pragma unroll
    for (int r = 0; r < 16; ++r) pmax = fmaxf(pmax, p1[r]);
    auto rr = __builtin_amdgcn_permlane32_swap(__float_as_uint(pmax), __float_as_uint(pmax), false, false);
    return fmaxf(__uint_as_float(rr[0]), __uint_as_float(rr[1]));
}
__device__ __forceinline__ void partialSM(f32x16& p0, f32x16& p1, float& m_reg, float& alpha) {
    const float pmax = rowmax32(p0, p1);
    float mn;
    if (__builtin_expect(__all(pmax - m_reg <= THR), 1)) { mn = m_reg; alpha = 1.f; }
    else { mn = fmaxf(m_reg, pmax); alpha = __builtin_amdgcn_exp2f(m_reg - mn); m_reg = mn; }
#pragma unroll
    for (int r = 0; r < 16; ++r) { p0[r] -= mn; p1[r] -= mn; }
#pragma unroll
    for (int r = 0; r < 16; ++r) p0[r] = __builtin_amdgcn_exp2f(p0[r]);
}
#define ATT_PK4(P, BASE, OUT) do { unsigned a0 = cvtpk(P[BASE + 0], P[BASE + 1]), a1 = cvtpk(P[BASE + 2], P[BASE + 3]);   \
    unsigned b0 = cvtpk(P[BASE + 4], P[BASE + 5]), b1 = cvtpk(P[BASE + 6], P[BASE + 7]);                              \
    auto r0 = __builtin_amdgcn_permlane32_swap(a0, b0, false, false); auto r1 = __builtin_amdgcn_permlane32_swap(a1, b1, false, false); \
    u32x4 w = {r0[0], r1[0], r0[1], r1[1]}; OUT = __builtin_bit_cast(bf16x8, w); } while (0)
__device__ __forceinline__ void finishSM(f32x16& p0, f32x16& p1, float alpha, float& l_reg, bf16x8& pa0, bf16x8& pa1, bf16x8& pa2, bf16x8& pa3) {
#pragma unroll
    for (int r = 0; r < 16; ++r) p1[r] = __builtin_amdgcn_exp2f(p1[r]);
    float ps = 0;
#pragma unroll
    for (int r = 0; r < 16; ++r) ps += p0[r];
#pragma unroll
    for (int r = 0; r < 16; ++r) ps += p1[r];
    { auto rr = __builtin_amdgcn_permlane32_swap(__float_as_uint(ps), __float_as_uint(ps), false, false); ps = __uint_as_float(rr[0]) + __uint_as_float(rr[1]); }
    l_reg = l_reg * alpha + ps;
    ATT_PK4(p0, 0, pa0); ATT_PK4(p0, 8, pa1); ATT_PK4(p1, 0, pa2); ATT_PK4(p1, 8, pa3);
}
template <int NA, int NB> __device__ __forceinline__ void qkt(f32x16& p0, f32x16& p1, const LAS unsigned char* KAs, const LAS unsigned char* KBs, const bf16x8* qr, int r32, int hi) {
    p0 = f32x16{}; p1 = f32x16{};
#pragma unroll
    for (int d0 = 0; d0 < NA; ++d0) { const int o = ka_off(r32, d0 * 2 + hi);
        const bf16x8 b0 = *(const LAS bf16x8*)(KAs + o), b1 = *(const LAS bf16x8*)(KAs + o + 4096);
        p0 = __builtin_amdgcn_mfma_f32_32x32x16_bf16(b0, qr[d0], p0, 0, 0, 0);
        p1 = __builtin_amdgcn_mfma_f32_32x32x16_bf16(b1, qr[d0], p1, 0, 0, 0); }
#pragma unroll
    for (int d0 = 0; d0 < NB; ++d0) { const int o = kb_off(r32, d0 * 2 + hi);
        const bf16x8 b0 = *(const LAS bf16x8*)(KBs + o), b1 = *(const LAS bf16x8*)(KBs + o + 2048);
        p0 = __builtin_amdgcn_mfma_f32_32x32x16_bf16(b0, qr[NA + d0], p0, 0, 0, 0);
        p1 = __builtin_amdgcn_mfma_f32_32x32x16_bf16(b1, qr[NA + d0], p1, 0, 0, 0); }
}
template <int DQKA, int DQKB, int DV> struct PassLay {
    static constexpr int VB = 64 * DV * 2, KAB = 64 * DQKA * 2, KBB = 64 * DQKB * 2, BUF = VB + KAB + KBB, WS_OFF = 2 * BUF, TOTAL = 2 * BUF + NWAVES * 256;
};
template <int DQKA, int DQKB, int DV>
__device__ __forceinline__ void attn_pass(const bf16_t* __restrict__ Qrow, const bf16_t* __restrict__ KA, int ldka, const bf16_t* __restrict__ KB, int ldkb,
                                          const bf16_t* __restrict__ V, int ldv, int NT, LAS unsigned char* lds, f32x16 (&o)[DV / 32], float& l_out) {
    constexpr int NA = DQKA / 16, NB = DQKB / 16, NCB = DV / 32, NVC = DV / 64;
    using L = PassLay<DQKA, DQKB, DV>;
    int tid_ = threadIdx.x; asm volatile("" : "+v"(tid_));
    const int tid = tid_, wid = tid >> 6, lane = tid & 63, r32 = lane & 31, hi = lane >> 5;
    LAS float* al_l = (LAS float*)(lds + L::WS_OFF) + wid * 64 + 32;
    float m_reg = -1e30f, l_reg = 0.f;
#pragma unroll
    for (int d = 0; d < DV / 32; ++d) o[d] = f32x16{};
    bf16x8 qr[NA + NB];
#pragma unroll
    for (int d0 = 0; d0 < NA + NB; ++d0) qr[d0] = *(const bf16x8*)(Qrow + d0 * 16 + hi * 8);
    const int vr0 = (NVC == 2) ? (tid >> 4) : (tid >> 3), vc = (NVC == 2) ? ((tid & 15) * 8) : ((tid & 7) * 8);
    const int vst0 = v_st<NCB>(vr0, vc), vst1 = v_st<NCB>(32 + vr0, vc);
    const int kar = tid >> 3, kac = tid & 7, kast = ka_off(kar, kac);
    const int kbr = (tid >> 2) & 63, kbc = tid & 3, kbst = kb_off(kbr, kbc);
    const bool kbon = (NB > 0) && (tid < 256);
    const unsigned vb0 = (unsigned)(uintptr_t)lds + (unsigned)v_rd_base(lane);
    struct Slot { bf16x8 v0, v1, ka, kb; } sS;
#define ATT_SLOAD(s, k0) do { (s).v0 = *(const bf16x8*)(V + (size_t)((k0) + vr0) * ldv + vc); \
        if (NVC == 2) (s).v1 = *(const bf16x8*)(V + (size_t)((k0) + 32 + vr0) * ldv + vc); \
        (s).ka = *(const bf16x8*)(KA + (size_t)((k0) + kar) * ldka + kac * 8); \
        if (kbon) (s).kb = *(const bf16x8*)(KB + (size_t)((k0) + kbr) * ldkb + kbc * 8); } while (0)
#define ATT_SWRITE(b, s) do { *(LAS bf16x8*)(lds + (b) * L::BUF + vst0) = (s).v0; \
        if (NVC == 2) *(LAS bf16x8*)(lds + (b) * L::BUF + vst1) = (s).v1; \
        *(LAS bf16x8*)(lds + (b) * L::BUF + L::VB + kast) = (s).ka; \
        if (kbon) *(LAS bf16x8*)(lds + (b) * L::BUF + L::VB + L::KAB + kbst) = (s).kb; } while (0)
#define ATT_RESC(a) do { if (__any((a) < 1.f)) { if (hi == 0) al_l[r32] = (a); asm volatile("s_waitcnt lgkmcnt(0)" ::: "memory"); \
        _Pragma("unroll") for (int d = 0; d < DV / 32; ++d) _Pragma("unroll") for (int r = 0; r < 16; ++r) o[d][r] *= al_l[crow(r, hi)]; } } while (0)
#define ATT_K0A (lds + L::VB)
#define ATT_K0B (lds + L::VB + L::KAB)
#define ATT_K1A (lds + L::BUF + L::VB)
#define ATT_K1B (lds + L::BUF + L::VB + L::KAB)
    f32x16 pA0, pA1, pB0, pB1; float alA, alB; bf16x8 pa0, pa1, pa2, pa3;
    __syncthreads();
    ATT_SLOAD(sS, 0); ATT_SWRITE(0, sS); __syncthreads();
    qkt<NA, NB>(pA0, pA1, ATT_K0A, ATT_K0B, qr, r32, hi); partialSM(pA0, pA1, m_reg, alA);
    ATT_SLOAD(sS, 64);
    ATT_SWRITE(1, sS); __syncthreads();
    for (int j = 1; j + 1 < NT; j += 2) {
        SBAR(); qkt<NA, NB>(pB0, pB1, ATT_K1A, ATT_K1B, qr, r32, hi);
        finishSM(pA0, pA1, alA, l_reg, pa0, pa1, pa2, pa3); SBAR();
        ATT_SLOAD(sS, (j + 1) * 64); SBAR();
        pv_all<NCB>(o, vb0, pa0, pa1, pa2, pa3); partialSM(pB0, pB1, m_reg, alB);
        __syncthreads(); ATT_SWRITE(0, sS);
        ATT_RESC(alB); __syncthreads();
        SBAR(); qkt<NA, NB>(pA0, pA1, ATT_K0A, ATT_K0B, qr, r32, hi);
        finishSM(pB0, pB1, alB, l_reg, pa0, pa1, pa2, pa3); SBAR();
        ATT_SLOAD(sS, (j + 2) * 64); SBAR();
        pv_all<NCB>(o, vb0 + L::BUF, pa0, pa1, pa2, pa3); partialSM(pA0, pA1, m_reg, alA);
        __syncthreads(); ATT_SWRITE(1, sS);
        ATT_RESC(alA); __syncthreads();
    }
    SBAR(); qkt<NA, NB>(pB0, pB1, ATT_K1A, ATT_K1B, qr, r32, hi);
    finishSM(pA0, pA1, alA, l_reg, pa0, pa1, pa2, pa3); SBAR();
    pv_all<NCB>(o, vb0, pa0, pa1, pa2, pa3); partialSM(pB0, pB1, m_reg, alB);
    ATT_RESC(alB);
    finishSM(pB0, pB1, alB, l_reg, pa0, pa1, pa2, pa3); SBAR();
    pv_all<NCB>(o, vb0 + L::BUF, pa0, pa1, pa2, pa3);
    l_out = l_reg;
#undef ATT_SLOAD
#undef ATT_SWRITE
#undef ATT_RESC
#undef ATT_K0A
#undef ATT_K0B
#undef ATT_K1A
#undef ATT_K1B
}
__device__ __forceinline__ void row_recip(float l_reg, LAS float* ws, int r32, int hi, float (&rli)[16]) {
    if (hi == 0) ws[r32] = l_reg;
    asm volatile("s_waitcnt lgkmcnt(0)" ::: "memory");
#pragma unroll
    for (int r = 0; r < 16; ++r) rli[r] = __builtin_amdgcn_rcpf(ws[crow(r, hi)]);
}
}

constexpr size_t MiB = 1u << 20;
constexpr size_t WS_CTL = 0, CTL_ZERO_BYTES = 1 * MiB;
constexpr size_t WS_MISC = 1 * MiB;
constexpr size_t WS_ROPEP = 2 * MiB;
constexpr size_t WS_ROPEC = 4 * MiB;
constexpr size_t WS_CQSSQ = 8 * MiB, WS_CKVSSQ = 8 * MiB + 512 * 1024;
constexpr size_t WS_W = 10 * MiB, W_LAYER = 28 * MiB;
constexpr size_t W_IN = 0, W_OUT = 5632 * 1024, W_MQ = 7680 * 1024, W_MKV = 8 * MiB, W_MO = 9 * MiB, W_GU = 9728 * 1024, W_DN = 20992 * 1024, W_QUP = 26 * MiB, W_KVUP = 26 * MiB + 256 * 1024;
constexpr size_t WS_MEMN = 66 * MiB;
constexpr size_t WS_MKV = 74 * MiB;
constexpr size_t WS_XN = 82 * MiB;
constexpr size_t WS_MIX = 146 * MiB;
constexpr size_t WS_R2 = 210 * MiB;
constexpr size_t WS_R1 = 274 * MiB;
constexpr size_t WS_STASH = 450 * MiB;
constexpr size_t WS_END = 482 * MiB;
static_assert(W_OUT == (size_t)2816 * 1024 * 2 && W_GU + (size_t)5632 * 1024 * 2 == W_DN && W_DN + (size_t)1024 * 2816 * 2 <= W_QUP && W_KVUP + 512 * 128 * 2 <= W_LAYER, "weight map");

struct Args { const void* in[18]; float* out; unsigned char* ws; int ph_lo, ph_hi; };
struct Frame {
    LAS unsigned char* lds;
    int tid, lane, wave, vcu, G;
    const __attribute__((address_space(4))) Args* a;
#define FIN(name, i, T) __device__ __forceinline__ const T* name() const { return (const T*)a->in[i]; }
    FIN(x, 0, float) FIN(mem, 1, float) FIN(pos, 2, int) FIN(gains, 3, float) FIN(w_in, 4, float) FIN(w_out, 5, float) FIN(dlam, 6, float) FIN(subln, 7, float)
    FIN(qnorm, 8, float) FIN(kvnorm, 9, float) FIN(w_qup, 10, float) FIN(w_kvup, 11, float) FIN(w_mq, 12, float) FIN(w_mkv, 13, float) FIN(w_mo, 14, float)
    FIN(w_gate, 15, float) FIN(w_up, 16, float) FIN(w_down, 17, float)
#undef FIN
    __device__ __forceinline__ float* out() const { return a->out; }
    __device__ __forceinline__ unsigned char* ws() const { return a->ws; }
#define FWS(name, off, T) __device__ __forceinline__ T* name() const { return (T*)(a->ws + (off)); }
    FWS(misc, WS_MISC, float) FWS(ropeP, WS_ROPEP, float) FWS(ropeC, WS_ROPEC, float) FWS(cqssq, WS_CQSSQ, float) FWS(ckvssq, WS_CKVSSQ, float) FWS(stash, WS_STASH, float)
    FWS(XN, WS_XN, bf16_t) FWS(MEMN, WS_MEMN, bf16_t) FWS(MKV, WS_MKV, bf16_t) FWS(MIX, WS_MIX, bf16_t) FWS(QC, WS_R2, bf16_t) FWS(KVC, WS_R2 + 32 * MiB, bf16_t) FWS(BR, WS_R2, bf16_t)
    FWS(QKV, WS_R1, bf16_t) FWS(H, WS_R1, bf16_t) FWS(MQ, WS_R1, bf16_t) FWS(MO, WS_R1 + 16 * MiB, bf16_t)
#undef FWS
};
__device__ __forceinline__ bf16_t* wptr(const Frame& F, int l, size_t off) { return (bf16_t*)(F.ws() + WS_W + (size_t)l * W_LAYER + off); }
__device__ __forceinline__ float wave_sum(float v) {
#pragma unroll
    for (int o = 1; o < 64; o <<= 1) v += __shfl_xor(v, o);
    return v;
}
__device__ __forceinline__ float bf2f(unsigned short u) { return __uint_as_float((unsigned)u << 16); }
typedef float f32x4_t __attribute__((ext_vector_type(4)));
typedef unsigned u32x2_t __attribute__((ext_vector_type(2)));

__device__ __forceinline__ void unit_A(const Frame& F, int l, int b, int h, int qb) {
    using namespace att;
    const int wid = F.wave, lane = F.lane, r32 = lane & 31, hi = lane >> 5;
    const int row0 = b * SEQ + qb * 256 + wid * 32;
    const bf16_t* kbase = F.QKV() + (size_t)(b * SEQ) * QKV_LD;
    float* stash = F.stash() + ((size_t)(blockIdx.x * NWAVES + wid) * 64) * 64 + lane;
    LAS float* ws = (LAS float*)(F.lds + PassLay<64, 0, 128>::WS_OFF) + wid * 64;
    f32x16 o[4]; float lsum; float rli[16];
#pragma unroll 1
    for (int map = 0; map < 2; ++map) {
        attn_pass<64, 0, 128>(F.QKV() + (size_t)(row0 + r32) * QKV_LD + h * 128 + map * 64, kbase + 512 + h * 128 + map * 64, QKV_LD, nullptr, 0,
                              kbase + 1024 + h * 128, QKV_LD, SEQ / 64, F.lds, o, lsum);
        row_recip(lsum, ws, r32, hi, rli);
        if (map == 0) {
#pragma unroll
            for (int d = 0; d < 4; ++d) { float* sp = stash + d * 1024; asm volatile("" : "+v"(sp));
#pragma unroll
                for (int r = 0; r < 16; ++r) sp[r * 64] = o[d][r] * rli[r]; }
        } else {
            const float lam = F.misc()[l], oml = F.misc()[2 + l];
#pragma unroll
            for (int d = 0; d < 4; ++d) { const float* sp = stash + d * 1024; asm volatile("" : "+v"(sp));
#pragma unroll
                for (int r = 0; r < 16; ++r) o[d][r] = sp[r * 64] - lam * (o[d][r] * rli[r]); }
            float gn[4];
#pragma unroll
            for (int d = 0; d < 4; ++d) gn[d] = F.subln()[l * 128 + d * 32 + r32] * oml;
            bf16_t* mixb = F.MIX() + (size_t)(row0 + 4 * hi) * DM + h * 128 + r32;
#pragma unroll
            for (int r = 0; r < 16; ++r) {
                float s = (o[0][r] * o[0][r] + o[1][r] * o[1][r]) + (o[2][r] * o[2][r] + o[3][r] * o[3][r]);
                s += __shfl_xor(s, 1); s += __shfl_xor(s, 2); s += __shfl_xor(s, 4); s += __shfl_xor(s, 8); s += __shfl_xor(s, 16);
                const float rstd = 1.0f / sqrtf(s * (1.0f / 128.0f) + NORM_EPS);
                bf16_t* dst = mixb + (size_t)((r & 3) + 8 * (r >> 2)) * DM; asm volatile("" : "+v"(dst));
#pragma unroll
                for (int d = 0; d < 4; ++d) dst[d * 32] = f2bf(o[d][r] * rstd * gn[d]);
            }
        }
    }
}
__device__ __forceinline__ void unit_C(const Frame& F, int b, int h, int qb) {
    using namespace att;
    const int wid = F.wave, lane = F.lane, r32 = lane & 31, hi = lane >> 5;
    const int row0 = b * SEQ + qb * 256 + wid * 32;
    LAS float* ws = (LAS float*)(F.lds + PassLay<64, 32, 64>::WS_OFF) + wid * 64;
    f32x16 o[2]; float lsum; float rli[16];
    const bf16_t* kvb = F.KVC() + (size_t)(b * SEQ) * 512 + h * 128;
    attn_pass<64, 32, 64>(F.QC() + (size_t)(row0 + r32) * 512 + h * 96, kvb, 512, F.QKV() + (size_t)(b * SEQ) * QKV_LD + 2688, QKV_LD, kvb + 64, 512, SEQ / 64, F.lds, o, lsum);
    row_recip(lsum, ws, r32, hi, rli);
    bf16_t* outb = F.MIX() + (size_t)(row0 + 4 * hi) * DM + 768 + h * 64 + r32;
#pragma unroll
    for (int r = 0; r < 16; ++r) { bf16_t* dst = outb + (size_t)((r & 3) + 8 * (r >> 2)) * DM; asm volatile("" : "+v"(dst));
#pragma unroll
        for (int d = 0; d < 2; ++d) dst[d * 32] = f2bf(o[d][r] * rli[r]); }
}
__device__ __forceinline__ void unit_M(const Frame& F, int l, int b, int h, int qb) {
    using namespace att;
    const int wid = F.wave, lane = F.lane, r32 = lane & 31, hi = lane >> 5;
    const int row0 = b * SEQ + qb * 256 + wid * 32;
    LAS float* ws = (LAS float*)(F.lds + PassLay<64, 0, 64>::WS_OFF) + wid * 64;
    f32x16 o[2]; float lsum; float rli[16];
    const bf16_t* kvb = F.MKV() + (size_t)l * MEMTOK * 512 + (size_t)(b * MEML) * 512 + h * 64;
    attn_pass<64, 0, 64>(F.MQ() + (size_t)(row0 + r32) * 256 + h * 64, kvb, 512, nullptr, 0, kvb + 256, 512, MEML / 64, F.lds, o, lsum);
    row_recip(lsum, ws, r32, hi, rli);
    bf16_t* outb = F.MO() + (size_t)(row0 + 4 * hi) * 256 + h * 64 + r32;
#pragma unroll
    for (int r = 0; r < 16; ++r) { bf16_t* dst = outb + (size_t)((r & 3) + 8 * (r >> 2)) * 256; asm volatile("" : "+v"(dst));
#pragma unroll
        for (int d = 0; d < 2; ++d) dst[d * 32] = f2bf(o[d][r] * rli[r]); }
}
__device__ __forceinline__ void dil_unit(const Frame& F, int b, int h, int r4, int a) {
    using namespace att;
    const int wid = F.wave, lane = F.lane, r32 = lane & 31, hi = lane >> 5;
    LAS unsigned char* vl = F.lds + wid * 8192;
    LAS float* ws = (LAS float*)(F.lds + 65536) + wid * 64;
    const unsigned vb = (unsigned)(uintptr_t)vl + (unsigned)v_rd_base(lane);
    const bf16_t* base = F.QKV() + (size_t)(b * SEQ) * QKV_LD;
    const int pq = 128 * a + 4 * r32 + r4;
    bf16x8 qr[4];
#pragma unroll
    for (int d0 = 0; d0 < 4; ++d0) qr[d0] = *(const bf16x8*)(base + (size_t)pq * QKV_LD + 1536 + h * 64 + d0 * 16 + hi * 8);
    float m_reg = -1e30f, l_reg = 0.f; f32x16 o[2]; o[0] = f32x16{}; o[1] = f32x16{};
#pragma unroll 1
    for (int ti = 0; ti < 19; ++ti) {
        int kb0, stride, lim, cls;
        if (ti < 3) { const int t = (ti == 0) ? 1 : (ti == 1 ? 0 : 2); kb0 = 128 * a - 256 + 256 * t + r4; stride = 4; lim = 256; cls = -1; }
        else if (ti < 7) { const int t = ti - 3; kb0 = 128 * a - 64 + 64 * t; stride = 1; lim = 64; cls = -1; }
        else { const int c = (ti - 7) / 3, t = (ti - 7) % 3; kb0 = 128 * a - 1024 + 1024 * t + 4 * c + r4; stride = 16; lim = 1024; cls = c; }
        if (kb0 + 63 * stride < 0 || kb0 >= SEQ) continue;
        f32x16 p0 = f32x16{}, p1 = f32x16{};
        {
            int k0p = kb0 + stride * r32, k1p = kb0 + stride * (32 + r32);
            k0p = k0p < 0 ? 0 : (k0p > SEQ - 1 ? SEQ - 1 : k0p); k1p = k1p < 0 ? 0 : (k1p > SEQ - 1 ? SEQ - 1 : k1p);
            const bf16_t* kp0 = base + (size_t)k0p * QKV_LD + 1792 + h * 64 + hi * 8;
            const bf16_t* kp1 = base + (size_t)k1p * QKV_LD + 1792 + h * 64 + hi * 8;
#pragma unroll
            for (int d0 = 0; d0 < 4; ++d0) { const bf16x8 b0 = *(const bf16x8*)(kp0 + d0 * 16), b1 = *(const bf16x8*)(kp1 + d0 * 16);
                p0 = __builtin_amdgcn_mfma_f32_32x32x16_bf16(b0, qr[d0], p0, 0, 0, 0);
                p1 = __builtin_amdgcn_mfma_f32_32x32x16_bf16(b1, qr[d0], p1, 0, 0, 0); }
        }
        bf16x8 vreg[8];
#pragma unroll
        for (int i = 0; i < 8; ++i) { int kp = kb0 + stride * (8 * i + (lane >> 3)); kp = kp < 0 ? 0 : (kp > SEQ - 1 ? SEQ - 1 : kp);
            vreg[i] = *(const bf16x8*)(base + (size_t)kp * QKV_LD + 2048 + h * 64 + (lane & 7) * 8); }
        const bool clsok = (cls < 0) || ((r32 & 3) == cls);
#pragma unroll
        for (int r = 0; r < 16; ++r) {
            const int kpa = kb0 + stride * crow(r, hi), kpb = kpa + 32 * stride;
            const int da = kpa - pq, db = kpb - pq;
            const bool va = clsok && kpa >= 0 && kpa < SEQ && da <= lim && da >= -lim;
            const bool vbb = clsok && kpb >= 0 && kpb < SEQ && db <= lim && db >= -lim;
            p0[r] = va ? p0[r] : -1e30f; p1[r] = vbb ? p1[r] : -1e30f;
        }
        const float pmax = rowmax32(p0, p1);
        const float mn = fmaxf(m_reg, pmax), alpha = __builtin_amdgcn_exp2f(m_reg - mn);
        m_reg = mn;
        float ps = 0.f;
#pragma unroll
        for (int r = 0; r < 16; ++r) { p0[r] = __builtin_amdgcn_exp2f(p0[r] - mn); p1[r] = __builtin_amdgcn_exp2f(p1[r] - mn); ps += p0[r] + p1[r]; }
        { auto rr = __builtin_amdgcn_permlane32_swap(__float_as_uint(ps), __float_as_uint(ps), false, false); ps = __uint_as_float(rr[0]) + __uint_as_float(rr[1]); }
        l_reg = l_reg * alpha + ps;
        if (hi == 0) ws[32 + r32] = alpha;
        bf16x8 pa0, pa1, pa2, pa3;
        ATT_PK4(p0, 0, pa0); ATT_PK4(p0, 8, pa1); ATT_PK4(p1, 0, pa2); ATT_PK4(p1, 8, pa3);
#pragma unroll
        for (int i = 0; i < 8; ++i) *(LAS bf16x8*)(vl + v_st<2>(8 * i + (lane >> 3), (lane & 7) * 8)) = vreg[i];
        asm volatile("s_waitcnt lgkmcnt(0)" ::: "memory");
#pragma unroll
        for (int d = 0; d < 2; ++d)
#pragma unroll
            for (int r = 0; r < 16; ++r) o[d][r] *= ws[32 + crow(r, hi)];
        pv_all<2>(o, vb, pa0, pa1, pa2, pa3);
    }
    float rli[16];
    row_recip(l_reg, ws, r32, hi, rli);
    bf16_t* outb = F.MIX() + (size_t)(b * SEQ + 128 * a + 16 * hi + r4) * DM + 512 + h * 64 + r32;
#pragma unroll
    for (int r = 0; r < 16; ++r) { bf16_t* dst = outb + (size_t)(4 * ((r & 3) + 8 * (r >> 2))) * DM; asm volatile("" : "+v"(dst));
#pragma unroll
        for (int d = 0; d < 2; ++d) dst[d * 32] = f2bf(o[d][r] * rli[r]); }
}

__device__ __forceinline__ void row_pass(const Frame& F, const float* xin, float* xout, const bf16_t* br, const float* g, bf16_t* xn) {
    const int gw = blockIdx.x * NWAVES + F.wave, NGW = F.G * NWAVES, lane = F.lane;
    f32x4_t gv[4];
#pragma unroll
    for (int j = 0; j < 4; ++j) gv[j] = *(const f32x4_t*)(g + 256 * j + 4 * lane);
    for (int m = gw; m < MTOK; m += NGW) {
        f32x4_t bv[4], xv[4]; float s = 0.f;
#pragma unroll
        for (int j = 0; j < 4; ++j) { const u32x2_t w = *(const u32x2_t*)(br + (size_t)m * DM + 256 * j + 4 * lane);
            bv[j][0] = __uint_as_float(w.x << 16); bv[j][1] = __uint_as_float(w.x & 0xffff0000u); bv[j][2] = __uint_as_float(w.y << 16); bv[j][3] = __uint_as_float(w.y & 0xffff0000u);
            xv[j] = *(const f32x4_t*)(xin + (size_t)m * DM + 256 * j + 4 * lane);
            s += (bv[j][0] * bv[j][0] + bv[j][1] * bv[j][1]) + (bv[j][2] * bv[j][2] + bv[j][3] * bv[j][3]); }
        const float rb = 1.0f / sqrtf(wave_sum(s) * (1.0f / DM) + NORM_EPS);
        float s2 = 0.f;
#pragma unroll
        for (int j = 0; j < 4; ++j) { xv[j] = xv[j] + bv[j] * rb * gv[j];
            *(f32x4_t*)(xout + (size_t)m * DM + 256 * j + 4 * lane) = xv[j];
            s2 += (xv[j][0] * xv[j][0] + xv[j][1] * xv[j][1]) + (xv[j][2] * xv[j][2] + xv[j][3] * xv[j][3]); }
        if (xn) {
            const float rx = 1.0f / sqrtf(wave_sum(s2) * (1.0f / DM) + NORM_EPS);
#pragma unroll
            for (int j = 0; j < 4; ++j) { u32x2_t w; w.x = pg8::cvt_pk_bf16(xv[j][0] * rx, xv[j][1] * rx); w.y = pg8::cvt_pk_bf16(xv[j][2] * rx, xv[j][3] * rx);
                *(u32x2_t*)(xn + (size_t)m * DM + 256 * j + 4 * lane) = w; }
        }
    }
}
__device__ __forceinline__ void norm_row(const float* src, bf16_t* dst, int lane) {
    f32x4_t v[4]; float s = 0.f;
#pragma unroll
    for (int j = 0; j < 4; ++j) { v[j] = *(const f32x4_t*)(src + 256 * j + 4 * lane); s += (v[j][0] * v[j][0] + v[j][1] * v[j][1]) + (v[j][2] * v[j][2] + v[j][3] * v[j][3]); }
    const float r = 1.0f / sqrtf(wave_sum(s) * (1.0f / DM) + NORM_EPS);
#pragma unroll
    for (int j = 0; j < 4; ++j) { u32x2_t w; w.x = pg8::cvt_pk_bf16(v[j][0] * r, v[j][1] * r); w.y = pg8::cvt_pk_bf16(v[j][2] * r, v[j][3] * r);
        *(u32x2_t*)(dst + 256 * j + 4 * lane) = w; }
}

__constant__ float ROPE_INV[24] = {1.000000000e+00f, 1.939227447e-01f, 3.760603093e-02f, 7.292664737e-03f, 1.414213562e-03f, 2.742481757e-04f, 5.318295897e-05f, 1.031338538e-05f, 1.000000000e+00f, 4.403666027e-01f, 1.939227447e-01f, 8.539710029e-02f, 3.760603093e-02f, 1.656044008e-02f, 7.292664737e-03f, 3.211445995e-03f, 1.414213562e-03f, 6.227724219e-04f, 2.742481757e-04f, 1.207697374e-04f, 5.318295897e-05f, 2.341999896e-05f, 1.031338538e-05f, 4.541670481e-06f};
__device__ __forceinline__ int orig16(int p) { return (p & 3) | ((p & 4) << 1) | ((p & 8) >> 1); }
__device__ __forceinline__ int origkr(int p) { return (p & 3) + 4 * (p >> 3) + 16 * ((p >> 2) & 1); }
constexpr int N_WKINDS = 9;
__device__ __forceinline__ int witems(int kind) {
    return kind == 0 ? 16 * 88 : kind == 1 ? 16 * 32 : kind == 2 ? 16 * 8 : kind == 3 ? 16 * 16 : kind == 4 ? 4 * 32 : kind == 5 ? 16 * 176 : kind == 6 ? 44 * 32 : kind == 7 ? 4 * 16 : 2 * 16;
}
__device__ __forceinline__ void wmap(int kind, int n, int& src, float& scale, bool& second) {
    src = n; scale = 1.f; second = false;
    if (kind == 0) {
        if (n >= DIN) { src = -1; return; }
        const bool qsec = (n < 512) || (n >= 1536 && n < 1792);
        const bool ropesec = (n < 1024) || (n >= 1536 && n < 2048);
        if (qsec) scale = 0.125f * LOG2E;
        if (ropesec && (n & 63) < 16) src = (n & ~15) | orig16(n & 15);
        if (n >= 2688) src = 2688 + origkr(n - 2688);
    } else if (kind == 2) { scale = 0.125f * LOG2E; }
    else if (kind == 5) { const int t = n >> 8, bj = (n >> 7) & 1, j = n & 127; src = t * 128 + j; second = (bj != 0); }
    else if (kind == 7) {
        if (n >= 384) { src = -1; return; }
        const int h = n / 96, w = n - 96 * h; src = 96 * h + (w < 64 ? w : 64 + origkr(w - 64)); scale = 0.10206207261596575f * LOG2E;
    }
}
__device__ __forceinline__ void prep_item(const Frame& F, int l, int kind, int item, LAS float* scr, int lane) {
    const float* g = F.gains() + (size_t)l * 7 * DM;
    const float* W; const float* W2 = nullptr; const float* gain = nullptr; bf16_t* dst; int K, Nsrc, Ndst;
    if (kind == 0)      { W = F.w_in() + (size_t)l * DM * DIN; gain = g; dst = wptr(F, l, W_IN); K = DM; Nsrc = DIN; Ndst = QKV_LD; }
    else if (kind == 1) { W = F.w_out() + (size_t)l * DM * DM; dst = wptr(F, l, W_OUT); K = DM; Nsrc = DM; Ndst = DM; }
    else if (kind == 2) { W = F.w_mq() + (size_t)l * DM * 256; gain = g + 2 * DM; dst = wptr(F, l, W_MQ); K = DM; Nsrc = 256; Ndst = 256; }
    else if (kind == 3) { W = F.w_mkv() + (size_t)l * DM * 512; gain = g + 3 * DM; dst = wptr(F, l, W_MKV); K = DM; Nsrc = 512; Ndst = 512; }
    else if (kind == 4) { W = F.w_mo() + (size_t)l * 256 * DM; dst = wptr(F, l, W_MO); K = 256; Nsrc = DM; Ndst = DM; }
    else if (kind == 5) { W = F.w_gate() + (size_t)l * DM * DFF; W2 = F.w_up() + (size_t)l * DM * DFF; gain = g + 5 * DM; dst = wptr(F, l, W_GU); K = DM; Nsrc = DFF; Ndst = 2 * DFF; }
    else if (kind == 6) { W = F.w_down() + (size_t)l * DFF * DM; dst = wptr(F, l, W_DN); K = DFF; Nsrc = DM; Ndst = DM; }
    else if (kind == 7) { W = F.w_qup() + (size_t)l * 256 * 384; gain = F.qnorm() + l * 256; dst = wptr(F, l, W_QUP); K = 256; Nsrc = 384; Ndst = 512; }
    else                { W = F.w_kvup() + (size_t)l * 128 * 512; gain = F.kvnorm() + l * 128; dst = wptr(F, l, W_KVUP); K = 128; Nsrc = 512; Ndst = 512; }
    const int nblk = Ndst / 32, kb = item / nblk, nb = item % nblk, k0 = 64 * kb, n0 = 32 * nb;
    int src; float scale; bool second; wmap(kind, n0 + (lane & 31), src, scale, second);
    if (second) W = W2;
#pragma unroll 8
    for (int i = 0; i < 32; ++i) { const int kk = 2 * i + (lane >> 5); float v = 0.f;
        if (src >= 0) { v = W[(size_t)(k0 + kk) * Nsrc + src] * scale; if (gain) v *= gain[k0 + kk]; }
        scr[kk * 33 + (lane & 31)] = v; }
    asm volatile("s_waitcnt lgkmcnt(0)" ::: "memory");
    const int c = lane & 7;
#pragma unroll
    for (int j = 0; j < 4; ++j) { const int n = (lane >> 3) + 8 * j; const LAS float* s = scr + (8 * c) * 33 + n;
        pg8::u32x4 o4; o4.x = pg8::cvt_pk_bf16(s[0 * 33], s[1 * 33]); o4.y = pg8::cvt_pk_bf16(s[2 * 33], s[3 * 33]); o4.z = pg8::cvt_pk_bf16(s[4 * 33], s[5 * 33]); o4.w = pg8::cvt_pk_bf16(s[6 * 33], s[7 * 33]);
        *(pg8::u32x4*)(dst + (size_t)(n0 + n) * K + k0 + 8 * c) = o4; }
    asm volatile("s_waitcnt lgkmcnt(0)" ::: "memory");
}
__device__ __forceinline__ void prologue(const Frame& F) {
    LAS float* scr = (LAS float*)(F.lds + F.wave * 16384);
    const int gw = blockIdx.x * NWAVES + F.wave, NGW = F.G * NWAVES;
    int per_layer = 0;
#pragma unroll
    for (int k = 0; k < N_WKINDS; ++k) per_layer += witems(k);
    for (int it = gw; it < 2 * per_layer; it += NGW) {
        const int l = it / per_layer; int r = it - l * per_layer, kind = 0;
        while (r >= witems(kind)) { r -= witems(kind); ++kind; }
        prep_item(F, l, kind, r, scr, F.lane);
    }
    for (int m = gw; m < MTOK; m += NGW) norm_row(F.x() + (size_t)m * DM, F.XN() + (size_t)m * DM, F.lane);
    for (int m = gw; m < MEMTOK; m += NGW) norm_row(F.mem() + (size_t)m * DM, F.MEMN() + (size_t)m * DM, F.lane);
    const int gt = blockIdx.x * (NWAVES * 64) + F.tid, NGT = F.G * NWAVES * 64;
    for (int i = gt; i < MTOK * 24; i += NGT) {
        const int row = i / 24, f = i - row * 24;
        const float p = (float)F.pos()[row];
        const float inv = ROPE_INV[f];
        const float ang = p * inv;
        const double t = (double)ang * 0.15915494309189535; const float fr = (float)(t - rint(t));
        const float cs = __builtin_amdgcn_cosf(fr), sn = __builtin_amdgcn_sinf(fr);
        if (f < 8) { F.ropeP()[(size_t)row * 16 + f] = cs; F.ropeP()[(size_t)row * 16 + 8 + f] = sn; }
        else { const int ff = f - 8; F.ropeC()[(size_t)row * 32 + ff] = cs; F.ropeC()[(size_t)row * 32 + 16 + ff] = sn; }
    }
    if (blockIdx.x == 0 && F.tid < 2) {
        const int l = F.tid; const float* lv = F.dlam() + l * 4 * 64; float s01 = 0.f, s23 = 0.f;
        for (int i = 0; i < 64; ++i) { s01 += lv[i] * lv[64 + i]; s23 += lv[128 + i] * lv[192 + i]; }
        const float lam_init = 0.8f - 0.6f * expf(-0.3f * (float)l);
        F.misc()[l] = expf(s01) - expf(s23) + lam_init; F.misc()[2 + l] = 1.0f - lam_init;
    }
}

constexpr int N_PHASES = 3 + 12 * DEPTH;
constexpr int ATT_LDS_MAX = att::PassLay<64, 0, 128>::TOTAL;
static_assert(ATT_LDS_MAX <= 131072 && att::PassLay<64, 32, 64>::TOTAL <= 131072, "attention LDS");

__global__ void __launch_bounds__(NWAVES * 64, 2) mk_fwd(Args args) {
    extern __shared__ __attribute__((aligned(16))) unsigned char lds_raw[];
    cg::grid_group grid = cg::this_grid();
    Frame F;
    F.lds = (LAS unsigned char*)lds_raw;
    F.tid = threadIdx.x; F.lane = F.tid & 63; F.wave = __builtin_amdgcn_readfirstlane(F.tid >> 6);
    F.G = gridDim.x; { const int bx = blockIdx.x; F.vcu = (F.G % 8 == 0) ? (bx % 8) * (F.G / 8) + bx / 8 : bx; }
    const __attribute__((address_space(4))) Args* ap = (const __attribute__((address_space(4))) Args*)__builtin_amdgcn_kernarg_segment_ptr();
    F.a = ap;
    unsigned char* ws = F.ws();

    volatile LAS unsigned* misc_lds = (volatile LAS unsigned*)(F.lds + 131072);
    for (int u = F.tid; u < 64; u += NWAVES * 64) misc_lds[u] = 0u;
    __syncthreads();
    XcdBarrier bar = xcd_barrier_post((unsigned*)(ws + WS_CTL) + 4096, misc_lds + 8);

    for (int ph = args.ph_lo; ph < args.ph_hi; ++ph) {
        { int t_ = threadIdx.x; asm volatile("" : "+v"(t_)); F.tid = t_; F.lane = t_ & 63; F.wave = __builtin_amdgcn_readfirstlane(t_ >> 6); const __attribute__((address_space(4))) Args* a_ = ap; asm volatile("" : "+s"(a_)); F.a = a_; }
        int l = 0, k = -1;
        if (ph == 0) k = -1; else if (ph <= 2) { k = -2; l = ph - 1; } else { l = (ph - 3) / 12; k = (ph - 3) % 12; }
        if (k == -1) {
#ifndef NO_PRO
            prologue(F);
#endif
        } else if (k == -2 || k == 3 || k == 5 || k == 7 || k == 10) {
            pg8::Gemm g; pg8::EpiPlain E; int c = (int)blockIdx.x;
            if (k == -2) { g = pg8::Gemm{F.MEMN(), wptr(F, l, W_MKV), MEMTOK, 512, DM, DM}; E = pg8::EpiPlain{F.MKV() + (size_t)l * MEMTOK * 512, 512}; c = (c + 128 * l) % F.G; }
            else if (k == 3) { g = pg8::Gemm{F.MIX(), wptr(F, l, W_OUT), MTOK, DM, DM, DM}; E = pg8::EpiPlain{F.BR(), DM}; }
            else if (k == 5) { g = pg8::Gemm{F.XN(), wptr(F, l, W_MQ), MTOK, 256, DM, DM}; E = pg8::EpiPlain{F.MQ(), 256}; }
            else if (k == 7) { g = pg8::Gemm{F.MO(), wptr(F, l, W_MO), MTOK, DM, 256, 256}; E = pg8::EpiPlain{F.BR(), DM}; }
            else { g = pg8::Gemm{F.H(), wptr(F, l, W_DN), MTOK, DM, DFF, DFF}; E = pg8::EpiPlain{F.BR(), DM}; }
            pg8::StaticOrder S; S.init(g.M, g.N, F.G, c);
#ifndef NO_PLAIN
            pg8::gemm_phase<pg8::EpiPlain, pg8::StaticOrder, true, true>(F.lds, g, S, E);
#endif
        } else if (k == 0) {
            pg8::Gemm g{F.XN(), wptr(F, l, W_IN), MTOK, QKV_LD, DM, DM}; pg8::StaticOrder S; S.init(MTOK, QKV_LD, F.G, (int)blockIdx.x);
            pg8::EpiQKV E{F.QKV(), F.ropeP(), F.ropeC(), F.cqssq(), F.ckvssq()};
#ifndef NO_QKV
            pg8::gemm_phase<pg8::EpiQKV, pg8::StaticOrder, true, true>(F.lds, g, S, E);
#endif
        } else if (k == 1) {
            int kq = 256, kkv = 128; asm volatile("" : "+s"(kq), "+s"(kkv));
            { pg8::Gemm g{F.QKV() + 2304, wptr(F, l, W_QUP), MTOK, 512, kq, QKV_LD}; pg8::StaticOrder S; S.init(MTOK, 512, F.G, (int)blockIdx.x);
              pg8::EpiMLA<true, 256> E{F.QC(), F.cqssq(), F.ropeC()};
#ifndef NO_MLA
              pg8::gemm_phase<pg8::EpiMLA<true, 256>, pg8::StaticOrder, true, true>(F.lds, g, S, E);
#endif
 }
            { pg8::Gemm g{F.QKV() + 2560, wptr(F, l, W_KVUP), MTOK, 512, kkv, QKV_LD}; pg8::StaticOrder S; S.init(MTOK, 512, F.G, (int)blockIdx.x);
              pg8::EpiMLA<false, 128> E{F.KVC(), F.ckvssq(), F.ropeC()};
#ifndef NO_MLA
              pg8::gemm_phase<pg8::EpiMLA<false, 128>, pg8::StaticOrder, true, true>(F.lds, g, S, E);
#endif
 }
        } else if (k == 2) {
#ifndef NO_A
#pragma unroll 1
            for (int i = 0; i < 2; ++i) { const int u = 2 * F.vcu + i; unit_A(F, l, u >> 5, (u >> 3) & 3, u & 7); }
#endif
#ifndef NO_C
#pragma unroll 1
            for (int i = 0; i < 2; ++i) { const int u = 2 * F.vcu + i; unit_C(F, u >> 5, (u >> 3) & 3, u & 7); }
#endif
            __syncthreads();
#ifndef NO_B
#pragma unroll 1
            for (int i = 0; i < 2; ++i) { const int w = (F.vcu * NWAVES + F.wave) + 2048 * i; dil_unit(F, w >> 8, (w >> 6) & 3, (w >> 4) & 3, w & 15); }
#endif
        } else if (k == 4 || k == 8 || k == 11) {
            const float* g = F.gains() + (size_t)l * 7 * DM + (k == 4 ? 1 : (k == 8 ? 4 : 6)) * DM;
#ifndef NO_ROW
            row_pass(F, (k == 4 && l == 0) ? F.x() : F.out(), F.out(), F.BR(), g, (k == 11 && l == DEPTH - 1) ? nullptr : F.XN());
#endif
        } else if (k == 6) {
#ifndef NO_M
#pragma unroll 1
            for (int i = 0; i < 2; ++i) { const int u = 2 * F.vcu + i; unit_M(F, l, u >> 5, (u >> 3) & 3, u & 7); }
#endif
        } else if (k == 9) {
            pg8::Gemm g{F.XN(), wptr(F, l, W_GU), MTOK, 2 * DFF, DM, DM}; pg8::StaticOrder S; S.init(MTOK, 2 * DFF, F.G, (int)blockIdx.x);
            pg8::EpiSwiGLU E{F.H()};
#ifndef NO_GU
            pg8::gemm_phase<pg8::EpiSwiGLU, pg8::StaticOrder, true, true>(F.lds, g, S, E);
#endif
        }
        if (ph + 1 < args.ph_hi && !(ph == 1 || ph == 2)) {
            if (ph == 0) { __threadfence(); grid.sync(); } else xcd_barrier(bar);
        }
    }
}

extern "C" void kernel_launch(void* const* d_in, const int* in_sizes, int n_in, void* d_out, int out_size, void* d_ws, size_t ws_size, hipStream_t stream) {
    static int grid = 0;
    if (grid == 0) {
        int dev = 0, cus = 0, per_cu = 0;
        if (n_in != 18 || in_sizes[0] != MTOK * DM || out_size != MTOK * DM || ws_size < WS_END) {
            fprintf(stderr, "kernel_launch: unexpected shapes / workspace (n_in %d, ws %zu < %zu?)\n", n_in, ws_size, (size_t)WS_END); grid = -1; return; }
        (void)hipGetDevice(&dev);
        (void)hipDeviceGetAttribute(&cus, hipDeviceAttributeMultiprocessorCount, dev);
        (void)hipFuncSetAttribute((const void*)mk_fwd, hipFuncAttributeMaxDynamicSharedMemorySize, LDS_BYTES);
        (void)hipOccupancyMaxActiveBlocksPerMultiprocessor(&per_cu, (const void*)mk_fwd, NWAVES * 64, LDS_BYTES);
        (void)hipGetLastError();
        grid = cus;
        if (per_cu < 1) fprintf(stderr, "kernel_launch: occupancy query says %d blocks per CU\n", per_cu);
    }
    if (grid < 0) return;
    (void)hipMemsetAsync((char*)d_ws + WS_CTL, 0, CTL_ZERO_BYTES, stream);
    Args a{};
    for (int i = 0; i < 18; ++i) a.in[i] = d_in[i];
    a.out = (float*)d_out; a.ws = (unsigned char*)d_ws;
#ifdef MK_SPLIT
    for (int ph = 0; ph < N_PHASES; ++ph) {
        if (ph == 1 || ph == 2) continue;
        a.ph_lo = (ph == 3) ? 1 : ph; a.ph_hi = ph + 1;
        void* kargs[] = {&a};
        hipError_t e = hipLaunchCooperativeKernel((const void*)mk_fwd, dim3(grid), dim3(NWAVES * 64), kargs, LDS_BYTES, stream);
        if (e != hipSuccess) { fprintf(stderr, "cooperative launch failed: %s (grid %d)\n", hipGetErrorString(e), grid); break; }
    }
#else
    a.ph_lo = 0; a.ph_hi = N_PHASES;
    void* kargs[] = {&a};
    hipError_t e = hipLaunchCooperativeKernel((const void*)mk_fwd, dim3(grid), dim3(NWAVES * 64), kargs, LDS_BYTES, stream);
    if (e != hipSuccess) fprintf(stderr, "cooperative launch failed: %s (grid %d)\n", hipGetErrorString(e), grid);
#endif
}
```

```cpp
#include <hip/hip_runtime.h>
#include <hip/hip_cooperative_groups.h>
#include <cstdio>
#include <cstdint>
namespace cg = cooperative_groups;

#define LAS __attribute__((address_space(3)))
constexpr int NWAVES = 8;
constexpr int LDS_BYTES = 147456;
constexpr int BATCH = 16, SEQ = 2048, DM = 1024, MTOK = BATCH * SEQ, DEPTH = 2;
constexpr int DIN = 2720, QKV_LD = 2816, DFF = 2816, MEML = 256, MEMTOK = BATCH * MEML;
constexpr float NORM_EPS = 1e-6f;
constexpr float LOG2E = 1.4426950408889634f;

#define XB_TMO      128
#define XB_XCNT(j)  (256  + 64 * (j))
#define XB_XSUB(j)  (1280 + 64 * (j))
#define XB_XGEN(j)  (2304 + 64 * (j))
#define XB_TOP      3328
#define XB_TOPGEN   3392
#define XCD_BAR_WORDS 3456
#define XB_SPIN_CAP (1u << 18)
__device__ __forceinline__ unsigned xb_ld(unsigned* p)              { return __hip_atomic_load(p, __ATOMIC_RELAXED, __HIP_MEMORY_SCOPE_AGENT); }
__device__ __forceinline__ unsigned xb_add(unsigned* p, unsigned v) { return __hip_atomic_fetch_add(p, v, __ATOMIC_RELAXED, __HIP_MEMORY_SCOPE_AGENT); }
__device__ __forceinline__ unsigned xb_xcc_id() { return (unsigned)__builtin_amdgcn_s_getreg((3 << 11) | 20) & 0xFu; }
#define XB_SPIN(cond, bar) do { unsigned _sp = 0; while (cond) { __builtin_amdgcn_s_sleep(1); \
    if ((++_sp & 255u) == 0u) { if (xb_ld(&(bar)[XB_TMO])) break; if (_sp > XB_SPIN_CAP) { atomicAdd(&(bar)[XB_TMO], 1u); break; } } } } while (0)
struct XcdBarrier { unsigned* bar; unsigned x; volatile LAS unsigned* st; };
__device__ __forceinline__ XcdBarrier xcd_barrier_post(unsigned* bar, volatile LAS unsigned* st) {
    XcdBarrier b; b.bar = bar; b.x = xb_xcc_id(); b.st = st;
    if (threadIdx.x == 0) (void)xb_add(&bar[XB_XCNT(b.x)], 1u);
    return b;
}
__device__ __forceinline__ void xcd_barrier_complete(unsigned* bar, unsigned x, unsigned& nloc, unsigned& nx) {
    const unsigned G = gridDim.x * gridDim.y * gridDim.z;
    unsigned sum, cnt, mine, sp = 0u;
    for (;;) {
        sum = 0u; cnt = 0u; mine = 0u;
#pragma unroll
        for (unsigned j = 0; j < 16; ++j) { const unsigned c = xb_ld(&bar[XB_XCNT(j)]); sum += c; cnt += (c > 0u) ? 1u : 0u; mine = (j == x) ? c : mine; }
        if (sum == G) break;
        __builtin_amdgcn_s_sleep(1);
        if ((++sp & 255u) == 0u) { if (xb_ld(&bar[XB_TMO])) break; if (sp > XB_SPIN_CAP) { atomicAdd(&bar[XB_TMO], 1u); break; } }
    }
    nloc = mine > 0u ? mine : 1u; nx = cnt > 0u ? cnt : 1u;
}
__device__ __forceinline__ void xcd_barrier(const XcdBarrier& b) {
    asm volatile("s_waitcnt vmcnt(0)" ::: "memory");
    __syncthreads();
    if (threadIdx.x == 0) {
        unsigned* bar = b.bar;
        __builtin_amdgcn_s_waitcnt(0);
        unsigned nloc = b.st[0], nx = b.st[1];
        if (nloc == 0u) { xcd_barrier_complete(bar, b.x, nloc, nx); b.st[0] = nloc; b.st[1] = nx; }
        const unsigned old = xb_add(&bar[XB_XSUB(b.x)], 1u);
        const unsigned gen = old / nloc;
        if (old + 1u == (gen + 1u) * nloc) {
            __builtin_amdgcn_fence(__ATOMIC_RELEASE, "agent");
            asm volatile("s_waitcnt vmcnt(0)" ::: "memory");
            const unsigned og = xb_add(&bar[XB_TOP], 1u);
            const unsigned tg = og / nx;
            if (og + 1u == (tg + 1u) * nx) xb_add(&bar[XB_TOPGEN], 1u);
            else XB_SPIN(xb_ld(&bar[XB_TOPGEN]) == tg, bar);
            __builtin_amdgcn_fence(__ATOMIC_ACQUIRE, "agent");
            xb_add(&bar[XB_XGEN(b.x)], 1u);
            asm volatile("s_waitcnt vmcnt(0)" ::: "memory");
        } else {
            XB_SPIN(xb_ld(&bar[XB_XGEN(b.x)]) == gen, bar);
            __builtin_amdgcn_fence(__ATOMIC_ACQUIRE, "agent");
            asm volatile("s_waitcnt vmcnt(0)" ::: "memory");
        }
    }
    __syncthreads();
}

namespace pg8 {
#define PG8_LAS __attribute__((address_space(3)))
typedef unsigned short bf16_t;
typedef short bf16x8 __attribute__((ext_vector_type(8)));
typedef float f32x4 __attribute__((ext_vector_type(4)));
typedef unsigned u32x4 __attribute__((ext_vector_type(4)));
constexpr int BM = 256, BK = 64, HALF = 128, HTB = HALF * BK * 2  , STAGE_BYTES = 8 * HTB, NXCD = 8, WGM = 8;

__host__ __device__ __forceinline__ int lds_byte(int r, int c) { const int st = (r >> 4) * 2 + (c >> 5), rr = r & 15, cc = c & 31, ob = rr * 64 + cc * 2; return st * 1024 + (ob ^ (((ob >> 9) & 1) << 5)); }
__host__ __device__ __forceinline__ void stage_rc(int b, int& R, int& C) { const int st = b / 1024, sb = b % 1024, swz = sb ^ (((sb >> 9) & 1) << 5); R = (st >> 1) * 16 + swz / 64; C = (st & 1) * 32 + (swz % 64) / 2; }
__host__ __device__ __forceinline__ int perm32(int rho) { const int n = rho >> 4, i = rho & 15; return 8 * (i >> 2) + 4 * n + (i & 3); }

struct Unit { int pm, pn; };
struct Gemm { const bf16_t* A; const bf16_t* Bt; int M, N, K, lda; };

struct StaticOrder {
    int nM, nN, nwg, G, c;
    __host__ __device__ void init(int M, int N, int G_, int c_) { nM = M / BM; nN = N / BM; nwg = nM * nN; G = G_; c = c_; }
    __host__ __device__ bool next(int i, Unit& u) const {
        const long L = (long)i * G + c; if (L >= nwg) return false;
        int wgid = (int)L; { const int q = nwg / NXCD, r = nwg % NXCD, xcd = wgid % NXCD, off = wgid / NXCD; wgid = (xcd < r ? xcd * (q + 1) : r * (q + 1) + (xcd - r) * q) + off; }
        const int nig = WGM * nN, gid = wgid / nig, fm = gid * WGM, gsz = (nM - fm) < WGM ? (nM - fm) : WGM;
        u.pm = fm + ((wgid % nig) % gsz); u.pn = (wgid % nig) / gsz; return true;
    }
    __device__ __forceinline__ void a_ready(const Unit&) const {}
    __device__ __forceinline__ void done(const Unit&) const {}
};

template <class Epi, class Sched, bool ALIGN_EPI = false, bool SP2 = false>
__device__ __forceinline__ void gemm_phase(PG8_LAS unsigned char* lds, const Gemm g, const Sched& S, const Epi& E) {
    int tid_ = threadIdx.x; asm volatile("" : "+v"(tid_));
    const int tid = tid_, wid = __builtin_amdgcn_readfirstlane(tid >> 6), lane = tid & 63, wr = wid >> 2, wc = wid & 3, fr = lane & 15, fq = lane >> 4;
    const int K = g.K, nt = K / BK;
    unsigned voffA[2], voffB[2];
#pragma unroll
    for (int i = 0; i < 2; ++i) { int R, C; stage_rc(tid * 16 + i * 8192, R, C); const int Rb = Epi::PERM ? ((R & ~31) + perm32(R & 31)) : R;
        voffA[i] = (unsigned)(R * g.lda + C) * 2u; voffB[i] = (unsigned)(Rb * K + C) * 2u; }
    const size_t kstep = (size_t)(BK * 2);
    const size_t hstepA = (size_t)HALF * g.lda * 2, hstepB = (size_t)HALF * K * 2;
    const size_t tstepA = 2 * hstepA, tstepB = 2 * hstepB;
    const unsigned ldsw = (unsigned)wid * 1024u;
    const int aoff = lds_byte(wr * 64 + fr, fq * 8), boff = lds_byte(wc * 32 + fr, fq * 8);
#define PG8_SA(b, h) (((b) * 2 + (h)) * HTB)
#define PG8_SB(b, h) ((4 + (b) * 2 + (h)) * HTB)
#define PG8_STAGE(bufoff, gbase, voff) do { _Pragma("unroll") for (int _i = 0; _i < 2; ++_i) \
        __builtin_amdgcn_global_load_lds((const unsigned*)((const char*)(gbase) + (voff)[_i]), (PG8_LAS unsigned*)(lds + (bufoff) + ldsw + _i * 8192), 16, 0, 0); } while (0)
#define PG8_LDA(dst, b, h) do { _Pragma("unroll") for (int m = 0; m < 4; ++m) _Pragma("unroll") for (int k = 0; k < 2; ++k) dst[m][k] = *(const PG8_LAS bf16x8*)(lds + PG8_SA(b, h) + aoff + m * 2048 + k * 1024); } while (0)
#define PG8_LDB(dst, b, h) do { _Pragma("unroll") for (int n = 0; n < 2; ++n) _Pragma("unroll") for (int k = 0; k < 2; ++k) dst[n][k] = *(const PG8_LAS bf16x8*)(lds + PG8_SB(b, h) + boff + n * 2048 + k * 1024); } while (0)
#define PG8_MMA(ai, bj, At, Bt) do { __builtin_amdgcn_s_setprio(1); _Pragma("unroll") for (int m = 0; m < 4; ++m) _Pragma("unroll") for (int n = 0; n < 2; ++n) _Pragma("unroll") for (int k = 0; k < 2; ++k) \
        acc[ai][bj][m][n] = __builtin_amdgcn_mfma_f32_16x16x32_bf16(Bt[n][k], At[m][k], acc[ai][bj][m][n], 0, 0, 0); __builtin_amdgcn_s_setprio(0); } while (0)
#define PG8_WAIT_V(n) asm volatile("s_waitcnt vmcnt(" #n ")" ::: "memory")
#define PG8_WAIT_L(n) asm volatile("s_waitcnt lgkmcnt(" #n ")" ::: "memory")
#define PG8_BAR __builtin_amdgcn_s_barrier()
#define PG8_SCHED __builtin_amdgcn_sched_barrier(0)
    Unit cur, nxt; int ui = 0;
    if (!S.next(0, cur)) return;
    f32x4 acc[2][2][4][2];
#pragma unroll
    for (int a = 0; a < 2; ++a)
#pragma unroll
        for (int b = 0; b < 2; ++b)
#pragma unroll
            for (int m = 0; m < 4; ++m)
#pragma unroll
                for (int n = 0; n < 2; ++n) acc[a][b][m][n] = (f32x4){0.f, 0.f, 0.f, 0.f};
    bf16x8 At[4][2], B0[2][2], B1[2][2];
    const char* cA = (const char*)g.A + (size_t)cur.pm * tstepA; const char* cB = (const char*)g.Bt + (size_t)cur.pn * tstepB;
    S.a_ready(cur);
    if constexpr (SP2) {
        PG8_STAGE(PG8_SB(0, 0), cB, voffB); PG8_STAGE(PG8_SB(0, 1), cB + hstepB, voffB); PG8_STAGE(PG8_SA(0, 0), cA, voffA); PG8_STAGE(PG8_SA(0, 1), cA + hstepA, voffA);
        if (wr == 1) PG8_BAR;
        PG8_WAIT_V(2); PG8_BAR;
        PG8_STAGE(PG8_SB(1, 0), cB + kstep, voffB); PG8_STAGE(PG8_SA(1, 0), cA + kstep, voffA); PG8_STAGE(PG8_SB(1, 1), cB + hstepB + kstep, voffB);
        PG8_WAIT_V(6); PG8_BAR;
    } else {
        PG8_STAGE(PG8_SB(0, 0), cB, voffB); PG8_STAGE(PG8_SA(0, 0), cA, voffA); PG8_STAGE(PG8_SB(0, 1), cB + hstepB, voffB); PG8_STAGE(PG8_SA(0, 1), cA + hstepA, voffA);
        if (wr == 1) PG8_BAR;
        PG8_WAIT_V(4); PG8_BAR;
        PG8_STAGE(PG8_SB(1, 0), cB + kstep, voffB); PG8_STAGE(PG8_SA(1, 0), cA + kstep, voffA); PG8_STAGE(PG8_SB(1, 1), cB + hstepB + kstep, voffB);
        PG8_WAIT_V(6); PG8_BAR;
    }
    for (;;) {
        const bool has_next = S.next(ui + 1, nxt);
        const char* nA = has_next ? (const char*)g.A + (size_t)nxt.pm * tstepA : cA; const char* nB = has_next ? (const char*)g.Bt + (size_t)nxt.pn * tstepB : cB;
        for (int t = 0; t < nt; t += 2) {
            const bool last = (t == nt - 2);
            const char* a1 = cA + (size_t)(t + 1) * kstep;
            const char* a2 = last ? nA : cA + (size_t)(t + 2) * kstep; const char* b2 = last ? nB : cB + (size_t)(t + 2) * kstep;
            const char* a3 = a2 + kstep; const char* b3 = b2 + kstep;
            if (last && has_next) S.a_ready(nxt);
            if constexpr (SP2) {
            PG8_LDB(B0, 0, 0); PG8_LDB(B1, 0, 1); PG8_SCHED; PG8_LDA(At, 0, 0); PG8_STAGE(PG8_SA(1, 1), a1 + hstepA, voffA);
            PG8_WAIT_V(8); PG8_WAIT_L(0); PG8_BAR; PG8_MMA(0, 0, At, B0); PG8_MMA(0, 1, At, B1); PG8_BAR; PG8_SCHED;
            PG8_LDA(At, 0, 1); PG8_STAGE(PG8_SB(0, 0), b2, voffB); PG8_STAGE(PG8_SB(0, 1), b2 + hstepB, voffB); PG8_STAGE(PG8_SA(0, 0), a2, voffA);
            PG8_WAIT_V(8); PG8_WAIT_L(0); PG8_BAR; PG8_MMA(1, 0, At, B0); PG8_MMA(1, 1, At, B1); PG8_BAR; PG8_SCHED;
            PG8_LDB(B0, 1, 0); PG8_LDB(B1, 1, 1); PG8_SCHED; PG8_LDA(At, 1, 0); PG8_STAGE(PG8_SA(0, 1), a2 + hstepA, voffA);
            PG8_WAIT_V(8); PG8_WAIT_L(0); PG8_BAR; PG8_MMA(0, 0, At, B0); PG8_MMA(0, 1, At, B1); PG8_BAR; PG8_SCHED;
            PG8_LDA(At, 1, 1); PG8_STAGE(PG8_SB(1, 0), b3, voffB); PG8_STAGE(PG8_SB(1, 1), b3 + hstepB, voffB); PG8_STAGE(PG8_SA(1, 0), a3, voffA);
            PG8_WAIT_V(8); PG8_WAIT_L(0); PG8_BAR; PG8_MMA(1, 0, At, B0); PG8_MMA(1, 1, At, B1); PG8_BAR; PG8_SCHED;
            } else {
            PG8_LDB(B0, 0, 0); PG8_SCHED; PG8_LDA(At, 0, 0); PG8_STAGE(PG8_SA(1, 1), a1 + hstepA, voffA);
            PG8_WAIT_L(8); PG8_BAR; PG8_WAIT_L(0); PG8_MMA(0, 0, At, B0); PG8_BAR; PG8_SCHED;
            PG8_LDB(B1, 0, 1); PG8_STAGE(PG8_SB(0, 0), b2, voffB);
            PG8_BAR; PG8_WAIT_L(0); PG8_MMA(0, 1, At, B1); PG8_BAR;
            PG8_LDA(At, 0, 1); PG8_STAGE(PG8_SA(0, 0), a2, voffA);
            PG8_BAR; PG8_WAIT_L(0); PG8_MMA(1, 0, At, B0); PG8_BAR; PG8_SCHED;
            PG8_STAGE(PG8_SB(0, 1), b2 + hstepB, voffB);
            PG8_WAIT_V(6); PG8_BAR; PG8_MMA(1, 1, At, B1); PG8_BAR;
            PG8_LDB(B0, 1, 0); PG8_SCHED; PG8_LDA(At, 1, 0); PG8_STAGE(PG8_SA(0, 1), a2 + hstepA, voffA);
            PG8_WAIT_L(8); PG8_BAR; PG8_WAIT_L(0); PG8_MMA(0, 0, At, B0); PG8_BAR; PG8_SCHED;
            PG8_LDB(B1, 1, 1); PG8_STAGE(PG8_SB(1, 0), b3, voffB);
            PG8_BAR; PG8_WAIT_L(0); PG8_MMA(0, 1, At, B1); PG8_BAR;
            PG8_LDA(At, 1, 1); PG8_STAGE(PG8_SA(1, 0), a3, voffA);
            PG8_BAR; PG8_WAIT_L(0); PG8_MMA(1, 0, At, B0); PG8_BAR; PG8_SCHED;
            PG8_STAGE(PG8_SB(1, 1), b3 + hstepB, voffB);
            PG8_WAIT_V(6); PG8_BAR; PG8_MMA(1, 1, At, B1); PG8_BAR;
            }
        }
        if constexpr (ALIGN_EPI) { if (wr == 0) PG8_BAR; }
        if constexpr (!Epi::AFTER_DRAIN) { E(acc, cur, wr, wc, fr, fq); S.done(cur); }
        if (!has_next) break;
#pragma unroll
        for (int a = 0; a < 2; ++a)
#pragma unroll
            for (int b = 0; b < 2; ++b)
#pragma unroll
                for (int m = 0; m < 4; ++m)
#pragma unroll
                    for (int n = 0; n < 2; ++n) acc[a][b][m][n] = (f32x4){0.f, 0.f, 0.f, 0.f};
        cur = nxt; cA = nA; cB = nB; ++ui;
        if constexpr (ALIGN_EPI) { if (wr == 1) PG8_BAR; }
    }
    PG8_WAIT_V(0);
    if constexpr (!ALIGN_EPI) { if (wr == 0) PG8_BAR; }
    PG8_BAR;
    if constexpr (Epi::AFTER_DRAIN) { E.fused(acc, cur, wr, wc, fr, fq, lds, wid, lane); S.done(cur); }
#undef PG8_SA
#undef PG8_SB
#undef PG8_STAGE
#undef PG8_LDA
#undef PG8_LDB
#undef PG8_MMA
#undef PG8_WAIT_V
#undef PG8_WAIT_L
#undef PG8_BAR
#undef PG8_SCHED
}
}

namespace pg8 {
__device__ __forceinline__ unsigned cvt_pk_bf16(float lo, float hi) { unsigned r; asm volatile("v_cvt_pk_bf16_f32 %0, %1, %2" : "=v"(r) : "v"(lo), "v"(hi)); return r; }
__device__ __forceinline__ void store8(bf16_t* p, const f32x4 v0, const f32x4 v1) {
    u32x4 w; w.x = cvt_pk_bf16(v0[0], v0[1]); w.y = cvt_pk_bf16(v0[2], v0[3]); w.z = cvt_pk_bf16(v1[0], v1[1]); w.w = cvt_pk_bf16(v1[2], v1[3]);
    *(u32x4*)p = w;
}
__device__ __forceinline__ void rot4(f32x4& a, f32x4& b, const f32x4 c, const f32x4 s) {
    const f32x4 x1 = a, x2 = b; a = x1 * c - x2 * s; b = x2 * c + x1 * s;
}
struct EpiPlain {
    static constexpr bool PERM = true, AFTER_DRAIN = false;
    bf16_t* O; int ldc; const float* rs;
    __device__ __forceinline__ void operator()(const f32x4 (&acc)[2][2][4][2], const Unit& u, int wr, int wc, int fr, int fq) const {
        const int row0 = u.pm * BM + wr * 64 + fr, col0 = u.pn * BM + wc * 32 + 8 * fq;
#pragma unroll
        for (int ai = 0; ai < 2; ++ai)
#pragma unroll
            for (int m = 0; m < 4; ++m) { const int row = row0 + ai * HALF + m * 16; bf16_t* rowp = O + (size_t)row * ldc + col0;
                const float sc = rs ? rs[row] : 1.0f;
#pragma unroll
                for (int bj = 0; bj < 2; ++bj) store8(rowp + bj * HALF, acc[ai][bj][m][0] * sc, acc[ai][bj][m][1] * sc);
                asm volatile("" ::: "memory"); }
    }
};
struct EpiQKV {
    static constexpr bool PERM = true, AFTER_DRAIN = false;
    bf16_t* O; const float* ropeP; const float* ropeC; float* cqssq; float* ckvssq; const float* rs;
    __device__ __forceinline__ void operator()(const f32x4 (&acc)[2][2][4][2], const Unit& u, int wr, int wc, int fr, int fq) const {
        const int pn = u.pn;
        const int row0 = u.pm * BM + wr * 64 + fr, col0 = pn * BM + wc * 32 + 8 * fq;
        const bool rope64 = ((pn < 4) || pn == 6 || pn == 7) && !(wc & 1) && (fq < 2);
        const bool ropekr = (pn == 10) && (wc == 0);
#pragma unroll
        for (int ai = 0; ai < 2; ++ai)
#pragma unroll
            for (int m = 0; m < 4; ++m) {
                const int row = row0 + ai * HALF + m * 16;
                f32x4 v[2][2];
#pragma unroll
                for (int bj = 0; bj < 2; ++bj) { v[bj][0] = acc[ai][bj][m][0] * rs[row]; v[bj][1] = acc[ai][bj][m][1] * rs[row]; }
                if (rope64) {
                    const f32x4 c = *(const f32x4*)(ropeP + (size_t)row * 16 + fq * 4), s = *(const f32x4*)(ropeP + (size_t)row * 16 + 8 + fq * 4);
                    rot4(v[0][0], v[0][1], c, s); rot4(v[1][0], v[1][1], c, s);
                }
                if (ropekr) {
                    const f32x4 c = *(const f32x4*)(ropeC + (size_t)row * 32 + fq * 4), s = *(const f32x4*)(ropeC + (size_t)row * 32 + 16 + fq * 4);
                    rot4(v[1][0], v[1][1], c, s);
                }
                if (pn == 9 || pn == 10) {
                    float ss = 0.f;
#pragma unroll
                    for (int e = 0; e < 4; ++e) ss += v[0][0][e] * v[0][0][e] + v[0][1][e] * v[0][1][e];
                    if (pn == 9) {
#pragma unroll
                        for (int e = 0; e < 4; ++e) ss += v[1][0][e] * v[1][0][e] + v[1][1][e] * v[1][1][e];
                    }
                    ss += __shfl_xor(ss, 16); ss += __shfl_xor(ss, 32);
                    if (fq == 0) { float* dst = (pn == 9) ? cqssq : ckvssq; dst[(size_t)row * 4 + wc] = ss; }
                }
                bf16_t* rowp = O + (size_t)row * QKV_LD + col0;
                store8(rowp, v[0][0], v[0][1]); store8(rowp + HALF, v[1][0], v[1][1]);
                asm volatile("" ::: "memory");
            }
    }
};
template <bool ROPE, int NCOLS> struct EpiMLA {
    static constexpr bool PERM = true, AFTER_DRAIN = false;
    bf16_t* O; const float* ssq; const float* ropeC;
    __device__ __forceinline__ void operator()(const f32x4 (&acc)[2][2][4][2], const Unit& u, int wr, int wc, int fr, int fq) const {
        const int row0 = u.pm * BM + wr * 64 + fr, col0 = u.pn * BM + wc * 32 + 8 * fq;
#pragma unroll
        for (int ai = 0; ai < 2; ++ai)
#pragma unroll
            for (int m = 0; m < 4; ++m) {
                const int row = row0 + ai * HALF + m * 16;
                const f32x4 p = *(const f32x4*)(ssq + (size_t)row * 4);
                const float rstd = __builtin_amdgcn_rsqf(((p[0] + p[1]) + (p[2] + p[3])) * (1.0f / NCOLS) + NORM_EPS);
#pragma unroll
                for (int bj = 0; bj < 2; ++bj) {
                    const int c0 = col0 + bj * HALF;
                    f32x4 v0 = acc[ai][bj][m][0] * rstd, v1 = acc[ai][bj][m][1] * rstd;
                    if (ROPE) { const int w = c0 % 96;
                        if (c0 < 384 && w >= 64) { const int f = (w - 64) >> 3;
                            const f32x4 c = *(const f32x4*)(ropeC + (size_t)row * 32 + f * 4), s = *(const f32x4*)(ropeC + (size_t)row * 32 + 16 + f * 4);
                            rot4(v0, v1, c, s); } }
                    store8(O + (size_t)row * 512 + c0, v0, v1);
                }
                asm volatile("" ::: "memory");
            }
    }
};
struct EpiSwiGLU {
    static constexpr bool PERM = true, AFTER_DRAIN = false;
    bf16_t* O; const float* rs;
    __device__ __forceinline__ void operator()(const f32x4 (&acc)[2][2][4][2], const Unit& u, int wr, int wc, int fr, int fq) const {
        const int row0 = u.pm * BM + wr * 64 + fr, col0 = u.pn * HALF + wc * 32 + 8 * fq;
#pragma unroll
        for (int ai = 0; ai < 2; ++ai)
#pragma unroll
            for (int m = 0; m < 4; ++m) {
                f32x4 hh[2]; const float sc = rs[row0 + ai * HALF + m * 16];
#pragma unroll
                for (int n = 0; n < 2; ++n) { const f32x4 g = acc[ai][0][m][n] * sc, uu = acc[ai][1][m][n] * sc;
#pragma unroll
                    for (int e = 0; e < 4; ++e) hh[n][e] = g[e] * uu[e] * __builtin_amdgcn_rcpf(1.0f + __builtin_amdgcn_exp2f(-g[e] * LOG2E)); }
                store8(O + (size_t)(row0 + ai * HALF + m * 16) * DFF + col0, hh[0], hh[1]);
                asm volatile("" ::: "memory");
            }
    }
};
}

typedef unsigned short bf16_t;
namespace att {
using bf16x8 = __attribute__((ext_vector_type(8))) short;
using s16x4  = __attribute__((ext_vector_type(4))) short;
using f32x16 = __attribute__((ext_vector_type(16))) float;
using u32x4  = __attribute__((ext_vector_type(4))) unsigned;
#define SBAR() __builtin_amdgcn_sched_barrier(0)
__device__ __forceinline__ int crow(int r, int hi) { return (r & 3) + 8 * (r >> 2) + 4 * hi; }
__device__ __forceinline__ unsigned cvtpk(float lo, float hi) { unsigned r; asm volatile("v_cvt_pk_bf16_f32 %0, %1, %2" : "=v"(r) : "v"(lo), "v"(hi)); return r; }
__device__ __forceinline__ unsigned short f2bf(float f) { unsigned u = __builtin_bit_cast(unsigned, f); return (unsigned short)((u + 0x7fffu + ((u >> 16) & 1u)) >> 16); }
__device__ __forceinline__ int ka_off(int row, int c) { return row * 128 + ((c ^ ((row >> 1) & 7)) << 4); }
__device__ __forceinline__ int kb_off(int row, int c) { return row * 64 + ((c ^ ((row >> 2) & 3)) << 4); }
template <int NCB> __device__ __forceinline__ int v_st(int k, int c) { const int kk = (k & ~0xC) | ((k & 4) << 1) | ((k & 8) >> 1); return ((kk >> 3) * NCB + (c >> 5)) * 512 + ((kk & 7) * 32 + (c & 31)) * 2; }
__device__ __forceinline__ int v_rd_base(int lane) { return ((lane & 3) << 3) | (((lane >> 2) & 3) << 6) | (((lane >> 4) & 1) << 5) | (((lane >> 5) & 1) << 8); }
template <int NCB> constexpr int v_rd_off(int d0, int ks, int half) { return d0 * 512 + ks * (2 * NCB * 512) + half * (NCB * 512); }
template <int OFF> __device__ __forceinline__ s16x4 tr_read(unsigned vb) {
    s16x4 r; asm volatile("ds_read_b64_tr_b16 %0, %1 offset:%2" : "=&v"(r) : "v"(vb), "i"(OFF) : "memory"); return r;
}
template <int D0, int NCB> __device__ __forceinline__ void pv_one(f32x16& od, unsigned vb, bf16x8 pa0, bf16x8 pa1, bf16x8 pa2, bf16x8 pa3) {
    const s16x4 l0 = tr_read<v_rd_off<NCB>(D0, 0, 0)>(vb), h0 = tr_read<v_rd_off<NCB>(D0, 0, 1)>(vb), l1 = tr_read<v_rd_off<NCB>(D0, 1, 0)>(vb), h1 = tr_read<v_rd_off<NCB>(D0, 1, 1)>(vb);
    const s16x4 l2 = tr_read<v_rd_off<NCB>(D0, 2, 0)>(vb), h2 = tr_read<v_rd_off<NCB>(D0, 2, 1)>(vb), l3 = tr_read<v_rd_off<NCB>(D0, 3, 0)>(vb), h3 = tr_read<v_rd_off<NCB>(D0, 3, 1)>(vb);
    asm volatile("s_waitcnt lgkmcnt(0)" ::: "memory"); SBAR();
#define ATT_PK(L, H) (bf16x8){L[0], L[1], L[2], L[3], H[0], H[1], H[2], H[3]}
    od = __builtin_amdgcn_mfma_f32_32x32x16_bf16(pa0, ATT_PK(l0, h0), od, 0, 0, 0);
    od = __builtin_amdgcn_mfma_f32_32x32x16_bf16(pa1, ATT_PK(l1, h1), od, 0, 0, 0);
    od = __builtin_amdgcn_mfma_f32_32x32x16_bf16(pa2, ATT_PK(l2, h2), od, 0, 0, 0);
    od = __builtin_amdgcn_mfma_f32_32x32x16_bf16(pa3, ATT_PK(l3, h3), od, 0, 0, 0);
#undef ATT_PK
}
template <int NCB> __device__ __forceinline__ void pv_all(f32x16* o, unsigned vb, bf16x8 pa0, bf16x8 pa1, bf16x8 pa2, bf16x8 pa3) {
    pv_one<0, NCB>(o[0], vb, pa0, pa1, pa2, pa3); pv_one<1, NCB>(o[1], vb, pa0, pa1, pa2, pa3);
    if constexpr (NCB == 4) { pv_one<2, NCB>(o[2], vb, pa0, pa1, pa2, pa3); pv_one<3, NCB>(o[3], vb, pa0, pa1, pa2, pa3); }
}
constexpr float THR = 8.f;
__device__ __forceinline__ float rowmax32(const f32x16& p0, const f32x16& p1) {
    float pmax = p0[0];
#pragma unroll
    for (int r = 1; r < 16; ++r) pmax = fmaxf(pmax, p0[r]);
#pragma unroll
    for (int r = 0; r < 16; ++r) pmax = fmaxf(pmax, p1[r]);
    auto rr = __builtin_amdgcn_permlane32_swap(__float_as_uint(pmax), __float_as_uint(pmax), false, false);
    return fmaxf(__uint_as_float(rr[0]), __uint_as_float(rr[1]));
}
__device__ __forceinline__ void partialSM(f32x16& p0, f32x16& p1, float& m_reg, float& alpha) {
    const float pmax = rowmax32(p0, p1);
    float mn;
    if (__builtin_expect(__all(pmax - m_reg <= THR), 1)) { mn = m_reg; alpha = 1.f; }
    else { mn = fmaxf(m_reg, pmax); alpha = __builtin_amdgcn_exp2f(m_reg - mn); m_reg = mn; }
#pragma unroll
    for (int r = 0; r < 16; ++r) { p0[r] -= mn; p1[r] -= mn; }
#pragma unroll
    for (int r = 0; r < 16; ++r) p0[r] = __builtin_amdgcn_exp2f(p0[r]);
}
#define ATT_PK4(P, BASE, OUT) do { unsigned a0 = cvtpk(P[BASE + 0], P[BASE + 1]), a1 = cvtpk(P[BASE + 2], P[BASE + 3]);   \
    unsigned b0 = cvtpk(P[BASE + 4], P[BASE + 5]), b1 = cvtpk(P[BASE + 6], P[BASE + 7]);                              \
    auto r0 = __builtin_amdgcn_permlane32_swap(a0, b0, false, false); auto r1 = __builtin_amdgcn_permlane32_swap(a1, b1, false, false); \
    u32x4 w = {r0[0], r1[0], r0[1], r1[1]}; OUT = __builtin_bit_cast(bf16x8, w); } while (0)
__device__ __forceinline__ void finishSM(f32x16& p0, f32x16& p1, float alpha, float& l_reg, bf16x8& pa0, bf16x8& pa1, bf16x8& pa2, bf16x8& pa3) {
#pragma unroll
    for (int r = 0; r < 16; ++r) p1[r] = __builtin_amdgcn_exp2f(p1[r]);
    float ps = 0;
#pragma unroll
    for (int r = 0; r < 16; ++r) ps += p0[r];
#pragma unroll
    for (int r = 0; r < 16; ++r) ps += p1[r];
    { auto rr = __builtin_amdgcn_permlane32_swap(__float_as_uint(ps), __float_as_uint(ps), false, false); ps = __uint_as_float(rr[0]) + __uint_as_float(rr[1]); }
    l_reg = l_reg * alpha + ps;
    ATT_PK4(p0, 0, pa0); ATT_PK4(p0, 8, pa1); ATT_PK4(p1, 0, pa2); ATT_PK4(p1, 8, pa3);
}
template <int NA, int NB> __device__ __forceinline__ void qkt(f32x16& p0, f32x16& p1, const LAS unsigned char* KAs, const LAS unsigned char* KBs, const bf16x8* qr, int r32, int hi) {
    p0 = f32x16{}; p1 = f32x16{};
#pragma unroll
    for (int d0 = 0; d0 < NA; ++d0) { const int o = ka_off(r32, d0 * 2 + hi);
        const bf16x8 b0 = *(const LAS bf16x8*)(KAs + o), b1 = *(const LAS bf16x8*)(KAs + o + 4096);
        p0 = __builtin_amdgcn_mfma_f32_32x32x16_bf16(b0, qr[d0], p0, 0, 0, 0);
        p1 = __builtin_amdgcn_mfma_f32_32x32x16_bf16(b1, qr[d0], p1, 0, 0, 0); }
#pragma unroll
    for (int d0 = 0; d0 < NB; ++d0) { const int o = kb_off(r32, d0 * 2 + hi);
        const bf16x8 b0 = *(const LAS bf16x8*)(KBs + o), b1 = *(const LAS bf16x8*)(KBs + o + 2048);
        p0 = __builtin_amdgcn_mfma_f32_32x32x16_bf16(b0, qr[NA + d0], p0, 0, 0, 0);
        p1 = __builtin_amdgcn_mfma_f32_32x32x16_bf16(b1, qr[NA + d0], p1, 0, 0, 0); }
}
template <int DQKA, int DQKB, int DV> struct PassLay {
    static constexpr int VB = 64 * DV * 2, KAB = 64 * DQKA * 2, KBB = 64 * DQKB * 2, BUF = VB + KAB + KBB, WS_OFF = 2 * BUF, TOTAL = 2 * BUF + NWAVES * 256;
};
template <int DQKA, int DQKB, int DV>
__device__ __forceinline__ void attn_pass(const bf16_t* __restrict__ Qrow, const bf16_t* __restrict__ KA, int ldka, const bf16_t* __restrict__ KB, int ldkb,
                                          const bf16_t* __restrict__ V, int ldv, int NT, LAS unsigned char* lds, f32x16 (&o)[DV / 32], float& l_out) {
    constexpr int NA = DQKA / 16, NB = DQKB / 16, NCB = DV / 32, NVC = DV / 64;
    using L = PassLay<DQKA, DQKB, DV>;
    int tid_ = threadIdx.x; asm volatile("" : "+v"(tid_));
    const int tid = tid_, wid = tid >> 6, lane = tid & 63, r32 = lane & 31, hi = lane >> 5;
    LAS float* al_l = (LAS float*)(lds + L::WS_OFF) + wid * 64 + 32;
    float m_reg = -1e30f, l_reg = 0.f;
#pragma unroll
    for (int d = 0; d < DV / 32; ++d) o[d] = f32x16{};
    bf16x8 qr[NA + NB];
#pragma unroll
    for (int d0 = 0; d0 < NA + NB; ++d0) qr[d0] = *(const bf16x8*)(Qrow + d0 * 16 + hi * 8);
    const int vr0 = (NVC == 2) ? (tid >> 4) : (tid >> 3), vc = (NVC == 2) ? ((tid & 15) * 8) : ((tid & 7) * 8);
    const int vst0 = v_st<NCB>(vr0, vc), vst1 = v_st<NCB>(32 + vr0, vc);
    const int kar = tid >> 3, kac = tid & 7, kast = ka_off(kar, kac);
    const int kbr = (tid >> 2) & 63, kbc = tid & 3, kbst = kb_off(kbr, kbc);
    const bool kbon = (NB > 0) && (tid < 256);
    const unsigned vb0 = (unsigned)(uintptr_t)lds + (unsigned)v_rd_base(lane);
    struct Slot { bf16x8 v0, v1, ka, kb; } sS;
#define ATT_SLOAD(s, k0) do { (s).v0 = *(const bf16x8*)(V + (size_t)((k0) + vr0) * ldv + vc); \
        if (NVC == 2) (s).v1 = *(const bf16x8*)(V + (size_t)((k0) + 32 + vr0) * ldv + vc); \
        (s).ka = *(const bf16x8*)(KA + (size_t)((k0) + kar) * ldka + kac * 8); \
        if (kbon) (s).kb = *(const bf16x8*)(KB + (size_t)((k0) + kbr) * ldkb + kbc * 8); } while (0)
#define ATT_SWRITE(b, s) do { *(LAS bf16x8*)(lds + (b) * L::BUF + vst0) = (s).v0; \
        if (NVC == 2) *(LAS bf16x8*)(lds + (b) * L::BUF + vst1) = (s).v1; \
        *(LAS bf16x8*)(lds + (b) * L::BUF + L::VB + kast) = (s).ka; \
        if (kbon) *(LAS bf16x8*)(lds + (b) * L::BUF + L::VB + L::KAB + kbst) = (s).kb; } while (0)
#define ATT_RESC(a) do { if (__any((a) < 1.f)) { if (hi == 0) al_l[r32] = (a); asm volatile("s_waitcnt lgkmcnt(0)" ::: "memory"); \
        _Pragma("unroll") for (int d = 0; d < DV / 32; ++d) _Pragma("unroll") for (int r = 0; r < 16; ++r) o[d][r] *= al_l[crow(r, hi)]; } } while (0)
#define ATT_K0A (lds + L::VB)
#define ATT_K0B (lds + L::VB + L::KAB)
#define ATT_K1A (lds + L::BUF + L::VB)
#define ATT_K1B (lds + L::BUF + L::VB + L::KAB)
    f32x16 pA0, pA1, pB0, pB1; float alA, alB; bf16x8 pa0, pa1, pa2, pa3;
    __syncthreads();
    ATT_SLOAD(sS, 0); ATT_SWRITE(0, sS); ATT_SLOAD(sS, 64); __syncthreads();
    qkt<NA, NB>(pA0, pA1, ATT_K0A, ATT_K0B, qr, r32, hi); partialSM(pA0, pA1, m_reg, alA);
    ATT_SWRITE(1, sS); if (2 < NT) ATT_SLOAD(sS, 128);
    __syncthreads();
    for (int j = 1; j + 1 < NT; j += 2) {
        SBAR(); qkt<NA, NB>(pB0, pB1, ATT_K1A, ATT_K1B, qr, r32, hi);
        finishSM(pA0, pA1, alA, l_reg, pa0, pa1, pa2, pa3); SBAR();
        pv_all<NCB>(o, vb0, pa0, pa1, pa2, pa3); partialSM(pB0, pB1, m_reg, alB);
        __syncthreads(); ATT_SWRITE(0, sS); ATT_SLOAD(sS, (j + 2) * 64);
        ATT_RESC(alB); __syncthreads();
        SBAR(); qkt<NA, NB>(pA0, pA1, ATT_K0A, ATT_K0B, qr, r32, hi);
        finishSM(pB0, pB1, alB, l_reg, pa0, pa1, pa2, pa3); SBAR();
        pv_all<NCB>(o, vb0 + L::BUF, pa0, pa1, pa2, pa3); partialSM(pA0, pA1, m_reg, alA);
        __syncthreads(); ATT_SWRITE(1, sS); if (j + 3 < NT) ATT_SLOAD(sS, (j + 3) * 64);
        ATT_RESC(alA); __syncthreads();
    }
    SBAR(); qkt<NA, NB>(pB0, pB1, ATT_K1A, ATT_K1B, qr, r32, hi);
    finishSM(pA0, pA1, alA, l_reg, pa0, pa1, pa2, pa3); SBAR();
    pv_all<NCB>(o, vb0, pa0, pa1, pa2, pa3); partialSM(pB0, pB1, m_reg, alB);
    ATT_RESC(alB);
    finishSM(pB0, pB1, alB, l_reg, pa0, pa1, pa2, pa3); SBAR();
    pv_all<NCB>(o, vb0 + L::BUF, pa0, pa1, pa2, pa3);
    l_out = l_reg;
#undef ATT_SLOAD
#undef ATT_SWRITE
#undef ATT_RESC
#undef ATT_K0A
#undef ATT_K0B
#undef ATT_K1A
#undef ATT_K1B
}
__device__ __forceinline__ void row_recip(float l_reg, LAS float* ws, int r32, int hi, float (&rli)[16]) {
    if (hi == 0) ws[r32] = l_reg;
    asm volatile("s_waitcnt lgkmcnt(0)" ::: "memory");
#pragma unroll
    for (int r = 0; r < 16; ++r) rli[r] = __builtin_amdgcn_rcpf(ws[crow(r, hi)]);
}
}

constexpr size_t MiB = 1u << 20;
constexpr size_t WS_CTL = 0, CTL_ZERO_BYTES = 1 * MiB;
constexpr size_t WS_MISC = 1 * MiB;
constexpr size_t WS_ROPEP = 2 * MiB;
constexpr size_t WS_ROPEC = 4 * MiB;
constexpr size_t WS_CQSSQ = 8 * MiB, WS_CKVSSQ = 8 * MiB + 512 * 1024;
constexpr size_t WS_W = 10 * MiB, W_LAYER = 28 * MiB;
constexpr size_t W_IN = 0, W_OUT = 5632 * 1024, W_MQ = 7680 * 1024, W_MKV = 8 * MiB, W_MO = 9 * MiB, W_GU = 9728 * 1024, W_DN = 20992 * 1024, W_QUP = 26 * MiB, W_KVUP = 26 * MiB + 256 * 1024;
constexpr size_t WS_MEMN = 66 * MiB;
constexpr size_t WS_MKV = 74 * MiB;
constexpr size_t WS_XB = 82 * MiB;
constexpr size_t WS_RS = 9 * MiB;
constexpr size_t WS_MIX = 146 * MiB;
constexpr size_t WS_R2 = 210 * MiB;
constexpr size_t WS_R1 = 274 * MiB;
constexpr size_t WS_STASH = 450 * MiB;
constexpr size_t WS_END = 482 * MiB;
static_assert(W_OUT == (size_t)2816 * 1024 * 2 && W_GU + (size_t)5632 * 1024 * 2 == W_DN && W_DN + (size_t)1024 * 2816 * 2 <= W_QUP && W_KVUP + 512 * 128 * 2 <= W_LAYER, "weight map");

struct Args { const void* in[18]; float* out; unsigned char* ws; int ph_lo, ph_hi; };
struct Frame {
    LAS unsigned char* lds;
    int tid, lane, wave, vcu, G;
    const __attribute__((address_space(4))) Args* a;
#define FIN(name, i, T) __device__ __forceinline__ const T* name() const { return (const T*)a->in[i]; }
    FIN(x, 0, float) FIN(mem, 1, float) FIN(pos, 2, int) FIN(gains, 3, float) FIN(w_in, 4, float) FIN(w_out, 5, float) FIN(dlam, 6, float) FIN(subln, 7, float)
    FIN(qnorm, 8, float) FIN(kvnorm, 9, float) FIN(w_qup, 10, float) FIN(w_kvup, 11, float) FIN(w_mq, 12, float) FIN(w_mkv, 13, float) FIN(w_mo, 14, float)
    FIN(w_gate, 15, float) FIN(w_up, 16, float) FIN(w_down, 17, float)
#undef FIN
    __device__ __forceinline__ float* out() const { return a->out; }
    __device__ __forceinline__ unsigned char* ws() const { return a->ws; }
#define FWS(name, off, T) __device__ __forceinline__ T* name() const { return (T*)(a->ws + (off)); }
    FWS(misc, WS_MISC, float) FWS(ropeP, WS_ROPEP, float) FWS(ropeC, WS_ROPEC, float) FWS(cqssq, WS_CQSSQ, float) FWS(ckvssq, WS_CKVSSQ, float) FWS(stash, WS_STASH, float)
    FWS(XB, WS_XB, bf16_t) FWS(RS, WS_RS, float) FWS(MEMN, WS_MEMN, bf16_t) FWS(MKV, WS_MKV, bf16_t) FWS(MIX, WS_MIX, bf16_t) FWS(QC, WS_R2, bf16_t) FWS(KVC, WS_R2 + 32 * MiB, bf16_t) FWS(BR, WS_R2, bf16_t)
    FWS(QKV, WS_R1, bf16_t) FWS(H, WS_R1, bf16_t) FWS(MQ, WS_R1, bf16_t) FWS(MO, WS_R1 + 16 * MiB, bf16_t)
#undef FWS
};
__device__ __forceinline__ bf16_t* wptr(const Frame& F, int l, size_t off) { return (bf16_t*)(F.ws() + WS_W + (size_t)l * W_LAYER + off); }
__device__ __forceinline__ float wave_sum(float v) {
#pragma unroll
    for (int o = 1; o < 64; o <<= 1) v += __shfl_xor(v, o);
    return v;
}
__device__ __forceinline__ float bf2f(unsigned short u) { return __uint_as_float((unsigned)u << 16); }
typedef float f32x4_t __attribute__((ext_vector_type(4)));
typedef unsigned u32x2_t __attribute__((ext_vector_type(2)));

__device__ __forceinline__ void unit_A(const Frame& F, int l, int b, int h, int qb) {
    using namespace att;
    const int wid = F.wave, lane = F.lane, r32 = lane & 31, hi = lane >> 5;
    const int row0 = b * SEQ + qb * 256 + wid * 32;
    const bf16_t* kbase = F.QKV() + (size_t)(b * SEQ) * QKV_LD;
    float* stash = F.stash() + ((size_t)(blockIdx.x * NWAVES + wid) * 64) * 64 + lane;
    LAS float* ws = (LAS float*)(F.lds + PassLay<64, 0, 128>::WS_OFF) + wid * 64;
    f32x16 o[4]; float lsum; float rli[16];
#pragma unroll 1
    for (int map = 0; map < 2; ++map) {
        attn_pass<64, 0, 128>(F.QKV() + (size_t)(row0 + r32) * QKV_LD + h * 128 + map * 64, kbase + 512 + h * 128 + map * 64, QKV_LD, nullptr, 0,
                              kbase + 1024 + h * 128, QKV_LD, SEQ / 64, F.lds, o, lsum);
        row_recip(lsum, ws, r32, hi, rli);
        if (map == 0) {
#pragma unroll
            for (int d = 0; d < 4; ++d) { float* sp = stash + d * 1024; asm volatile("" : "+v"(sp));
#pragma unroll
                for (int r = 0; r < 16; ++r) sp[r * 64] = o[d][r] * rli[r]; }
        } else {
            const float lam = F.misc()[l], oml = F.misc()[2 + l];
#pragma unroll
            for (int d = 0; d < 4; ++d) { const float* sp = stash + d * 1024; asm volatile("" : "+v"(sp));
#pragma unroll
                for (int r = 0; r < 16; ++r) o[d][r] = sp[r * 64] - lam * (o[d][r] * rli[r]); }
            float gn[4];
#pragma unroll
            for (int d = 0; d < 4; ++d) gn[d] = F.subln()[l * 128 + d * 32 + r32] * oml;
            bf16_t* mixb = F.MIX() + (size_t)(row0 + 4 * hi) * DM + h * 128 + r32;
#pragma unroll
            for (int r = 0; r < 16; ++r) {
                float s = (o[0][r] * o[0][r] + o[1][r] * o[1][r]) + (o[2][r] * o[2][r] + o[3][r] * o[3][r]);
                s += __shfl_xor(s, 1); s += __shfl_xor(s, 2); s += __shfl_xor(s, 4); s += __shfl_xor(s, 8); s += __shfl_xor(s, 16);
                const float rstd = 1.0f / sqrtf(s * (1.0f / 128.0f) + NORM_EPS);
                bf16_t* dst = mixb + (size_t)((r & 3) + 8 * (r >> 2)) * DM; asm volatile("" : "+v"(dst));
#pragma unroll
                for (int d = 0; d < 4; ++d) dst[d * 32] = f2bf(o[d][r] * rstd * gn[d]);
            }
        }
    }
}
__device__ __forceinline__ void unit_C(const Frame& F, int b, int h, int qb) {
    using namespace att;
    const int wid = F.wave, lane = F.lane, r32 = lane & 31, hi = lane >> 5;
    const int row0 = b * SEQ + qb * 256 + wid * 32;
    LAS float* ws = (LAS float*)(F.lds + PassLay<64, 32, 64>::WS_OFF) + wid * 64;
    f32x16 o[2]; float lsum; float rli[16];
    const bf16_t* kvb = F.KVC() + (size_t)(b * SEQ) * 512 + h * 128;
    attn_pass<64, 32, 64>(F.QC() + (size_t)(row0 + r32) * 512 + h * 96, kvb, 512, F.QKV() + (size_t)(b * SEQ) * QKV_LD + 2688, QKV_LD, kvb + 64, 512, SEQ / 64, F.lds, o, lsum);
    row_recip(lsum, ws, r32, hi, rli);
    bf16_t* outb = F.MIX() + (size_t)(row0 + 4 * hi) * DM + 768 + h * 64 + r32;
#pragma unroll
    for (int r = 0; r < 16; ++r) { bf16_t* dst = outb + (size_t)((r & 3) + 8 * (r >> 2)) * DM; asm volatile("" : "+v"(dst));
#pragma unroll
        for (int d = 0; d < 2; ++d) dst[d * 32] = f2bf(o[d][r] * rli[r]); }
}
__device__ __forceinline__ void unit_M(const Frame& F, int l, int b, int h, int qb) {
    using namespace att;
    const int wid = F.wave, lane = F.lane, r32 = lane & 31, hi = lane >> 5;
    const int row0 = b * SEQ + qb * 256 + wid * 32;
    LAS float* ws = (LAS float*)(F.lds + PassLay<64, 0, 64>::WS_OFF) + wid * 64;
    f32x16 o[2]; float lsum; float rli[16];
    const bf16_t* kvb = F.MKV() + (size_t)l * MEMTOK * 512 + (size_t)(b * MEML) * 512 + h * 64;
    attn_pass<64, 0, 64>(F.MQ() + (size_t)(row0 + r32) * 256 + h * 64, kvb, 512, nullptr, 0, kvb + 256, 512, MEML / 64, F.lds, o, lsum);
    row_recip(lsum, ws, r32, hi, rli);
    bf16_t* outb = F.MO() + (size_t)(row0 + 4 * hi) * 256 + h * 64 + r32;
#pragma unroll
    for (int r = 0; r < 16; ++r) { bf16_t* dst = outb + (size_t)((r & 3) + 8 * (r >> 2)) * 256; asm volatile("" : "+v"(dst));
#pragma unroll
        for (int d = 0; d < 2; ++d) dst[d * 32] = f2bf(o[d][r] * rli[r]); }
}
__device__ __forceinline__ void dil_tile(int ti, int a, int r4, int& kb0, int& stride, int& lim, int& cls) {
    if (ti < 3) { const int t = (ti == 0) ? 1 : (ti == 1 ? 0 : 2); kb0 = 128 * a - 256 + 256 * t + r4; stride = 4; lim = 256; cls = -1; }
    else if (ti < 7) { const int t = ti - 3; kb0 = 128 * a - 64 + 64 * t; stride = 1; lim = 64; cls = -1; }
    else { const int c = (ti - 7) / 3, t = (ti - 7) % 3; kb0 = 128 * a - 1024 + 1024 * t + 4 * c + r4; stride = 16; lim = 1024; cls = c; }
}
__device__ __forceinline__ int clampi(int v, int lo, int hi) { return v < lo ? lo : (v > hi ? hi : v); }
#define DIL_LOADK(KF, ti_) do { int kb0_, st_, lim_, cls_; dil_tile((ti_) < 19 ? (ti_) : 18, a, r4, kb0_, st_, lim_, cls_); \
        const bf16_t* kp0_ = base + (size_t)clampi(kb0_ + st_ * r32, 0, SEQ - 1) * QKV_LD + 1792 + h * 64 + hi * 8; \
        const bf16_t* kp1_ = base + (size_t)clampi(kb0_ + st_ * (32 + r32), 0, SEQ - 1) * QKV_LD + 1792 + h * 64 + hi * 8; \
        _Pragma("unroll") for (int d0 = 0; d0 < 4; ++d0) { KF[d0] = *(const bf16x8*)(kp0_ + d0 * 16); KF[4 + d0] = *(const bf16x8*)(kp1_ + d0 * 16); } } while (0)
#define DIL_STEP(KF, KN, ti_) do { int kb0, stride, lim, cls; dil_tile((ti_), a, r4, kb0, stride, lim, cls); \
        DIL_LOADK(KN, (ti_) + 1); \
        if (!(kb0 + 63 * stride < 0 || kb0 >= SEQ)) { \
        bf16x8 VF[8]; \
        _Pragma("unroll") for (int i = 0; i < 8; ++i) VF[i] = *(const bf16x8*)(base + (size_t)clampi(kb0 + stride * (8 * i + (lane >> 3)), 0, SEQ - 1) * QKV_LD + 2048 + h * 64 + (lane & 7) * 8); \
        f32x16 p0 = f32x16{}, p1 = f32x16{}; \
        _Pragma("unroll") for (int d0 = 0; d0 < 4; ++d0) { p0 = __builtin_amdgcn_mfma_f32_32x32x16_bf16(KF[d0], qr[d0], p0, 0, 0, 0); p1 = __builtin_amdgcn_mfma_f32_32x32x16_bf16(KF[4 + d0], qr[d0], p1, 0, 0, 0); } \
        const bool clsok = (cls < 0) || ((r32 & 3) == cls); \
        _Pragma("unroll") for (int r = 0; r < 16; ++r) { \
            const int kpa = kb0 + stride * crow(r, hi), kpb = kpa + 32 * stride; const int da = kpa - pq, db = kpb - pq; \
            const bool va = clsok && kpa >= 0 && kpa < SEQ && da <= lim && da >= -lim; const bool vbb = clsok && kpb >= 0 && kpb < SEQ && db <= lim && db >= -lim; \
            p0[r] = va ? p0[r] : -1e30f; p1[r] = vbb ? p1[r] : -1e30f; } \
        const float pmax = rowmax32(p0, p1); const float mn = fmaxf(m_reg, pmax), alpha = __builtin_amdgcn_exp2f(m_reg - mn); m_reg = mn; \
        float ps = 0.f; \
        _Pragma("unroll") for (int r = 0; r < 16; ++r) { p0[r] = __builtin_amdgcn_exp2f(p0[r] - mn); p1[r] = __builtin_amdgcn_exp2f(p1[r] - mn); ps += p0[r] + p1[r]; } \
        { auto rr = __builtin_amdgcn_permlane32_swap(__float_as_uint(ps), __float_as_uint(ps), false, false); ps = __uint_as_float(rr[0]) + __uint_as_float(rr[1]); } \
        l_reg = l_reg * alpha + ps; \
        if (hi == 0) ws[32 + r32] = alpha; \
        bf16x8 pa0, pa1, pa2, pa3; ATT_PK4(p0, 0, pa0); ATT_PK4(p0, 8, pa1); ATT_PK4(p1, 0, pa2); ATT_PK4(p1, 8, pa3); \
        _Pragma("unroll") for (int i = 0; i < 8; ++i) *(LAS bf16x8*)(vl + v_st<2>(8 * i + (lane >> 3), (lane & 7) * 8)) = VF[i]; \
        asm volatile("s_waitcnt lgkmcnt(0)" ::: "memory"); \
        _Pragma("unroll") for (int d = 0; d < 2; ++d) _Pragma("unroll") for (int r = 0; r < 16; ++r) o[d][r] *= ws[32 + crow(r, hi)]; \
        pv_all<2>(o, vb, pa0, pa1, pa2, pa3); } } while (0)
__device__ __forceinline__ void dil_unit(const Frame& F, int b, int h, int r4, int a) {
    using namespace att;
    const int wid = F.wave, lane = F.lane, r32 = lane & 31, hi = lane >> 5;
    LAS unsigned char* vl = F.lds + wid * 8192;
    LAS float* ws = (LAS float*)(F.lds + 65536) + wid * 64;
    const unsigned vb = (unsigned)(uintptr_t)vl + (unsigned)v_rd_base(lane);
    const bf16_t* base = F.QKV() + (size_t)(b * SEQ) * QKV_LD;
    const int pq = 128 * a + 4 * r32 + r4;
    bf16x8 qr[4];
#pragma unroll
    for (int d0 = 0; d0 < 4; ++d0) qr[d0] = *(const bf16x8*)(base + (size_t)pq * QKV_LD + 1536 + h * 64 + d0 * 16 + hi * 8);
    float m_reg = -1e30f, l_reg = 0.f; f32x16 o[2]; o[0] = f32x16{}; o[1] = f32x16{};
    bf16x8 kA[8], kB[8];
    DIL_LOADK(kA, 0);
#pragma unroll 1
    for (int ti = 0; ti < 19; ti += 2) {
        DIL_STEP(kA, kB, ti);
        if (ti + 1 < 19) DIL_STEP(kB, kA, ti + 1);
    }
    float rli[16];
    row_recip(l_reg, ws, r32, hi, rli);
    bf16_t* outb = F.MIX() + (size_t)(b * SEQ + 128 * a + 16 * hi + r4) * DM + 512 + h * 64 + r32;
#pragma unroll
    for (int r = 0; r < 16; ++r) { bf16_t* dst = outb + (size_t)(4 * ((r & 3) + 8 * (r >> 2))) * DM; asm volatile("" : "+v"(dst));
#pragma unroll
        for (int d = 0; d < 2; ++d) dst[d * 32] = f2bf(o[d][r] * rli[r]); }
}
#undef DIL_LOADK
#undef DIL_STEP

__device__ __forceinline__ void row_pass(const Frame& F, const bf16_t* xb_in, const bf16_t* br, const float* g, bf16_t* xb_out, float* rs_out, float* fout) {
    const int gw = blockIdx.x * NWAVES + F.wave, NGW = F.G * NWAVES, lane = F.lane;
    f32x4_t gv[4];
#pragma unroll
    for (int j = 0; j < 4; ++j) gv[j] = *(const f32x4_t*)(g + 256 * j + 4 * lane);
    for (int m = gw; m < MTOK; m += NGW) {
        f32x4_t bv[4], xv[4]; float s = 0.f;
#pragma unroll
        for (int j = 0; j < 4; ++j) { const u32x2_t w = *(const u32x2_t*)(br + (size_t)m * DM + 256 * j + 4 * lane), xw = *(const u32x2_t*)(xb_in + (size_t)m * DM + 256 * j + 4 * lane);
            bv[j][0] = __uint_as_float(w.x << 16); bv[j][1] = __uint_as_float(w.x & 0xffff0000u); bv[j][2] = __uint_as_float(w.y << 16); bv[j][3] = __uint_as_float(w.y & 0xffff0000u);
            xv[j][0] = __uint_as_float(xw.x << 16); xv[j][1] = __uint_as_float(xw.x & 0xffff0000u); xv[j][2] = __uint_as_float(xw.y << 16); xv[j][3] = __uint_as_float(xw.y & 0xffff0000u);
            s += (bv[j][0] * bv[j][0] + bv[j][1] * bv[j][1]) + (bv[j][2] * bv[j][2] + bv[j][3] * bv[j][3]); }
        const float rb = 1.0f / sqrtf(wave_sum(s) * (1.0f / DM) + NORM_EPS);
#pragma unroll
        for (int j = 0; j < 4; ++j) xv[j] = xv[j] + bv[j] * rb * gv[j];
        if (fout) {
#pragma unroll
            for (int j = 0; j < 4; ++j) *(f32x4_t*)(fout + (size_t)m * DM + 256 * j + 4 * lane) = xv[j];
        } else {
            float s2 = 0.f;
#pragma unroll
            for (int j = 0; j < 4; ++j) { u32x2_t w; w.x = pg8::cvt_pk_bf16(xv[j][0], xv[j][1]); w.y = pg8::cvt_pk_bf16(xv[j][2], xv[j][3]);
                *(u32x2_t*)(xb_out + (size_t)m * DM + 256 * j + 4 * lane) = w;
                const float a0 = __uint_as_float(w.x << 16), a1 = __uint_as_float(w.x & 0xffff0000u), a2 = __uint_as_float(w.y << 16), a3 = __uint_as_float(w.y & 0xffff0000u);
                s2 += (a0 * a0 + a1 * a1) + (a2 * a2 + a3 * a3); }
            const float rx = 1.0f / sqrtf(wave_sum(s2) * (1.0f / DM) + NORM_EPS);
            if (lane == 0) rs_out[m] = rx;
        }
    }
}
__device__ __forceinline__ void norm_row(const float* src, bf16_t* dst, int lane) {
    f32x4_t v[4]; float s = 0.f;
#pragma unroll
    for (int j = 0; j < 4; ++j) { v[j] = *(const f32x4_t*)(src + 256 * j + 4 * lane); s += (v[j][0] * v[j][0] + v[j][1] * v[j][1]) + (v[j][2] * v[j][2] + v[j][3] * v[j][3]); }
    const float r = 1.0f / sqrtf(wave_sum(s) * (1.0f / DM) + NORM_EPS);
#pragma unroll
    for (int j = 0; j < 4; ++j) { u32x2_t w; w.x = pg8::cvt_pk_bf16(v[j][0] * r, v[j][1] * r); w.y = pg8::cvt_pk_bf16(v[j][2] * r, v[j][3] * r);
        *(u32x2_t*)(dst + 256 * j + 4 * lane) = w; }
}

__constant__ float ROPE_INV[24] = {1.000000000e+00f, 1.939227447e-01f, 3.760603093e-02f, 7.292664737e-03f, 1.414213562e-03f, 2.742481757e-04f, 5.318295897e-05f, 1.031338538e-05f, 1.000000000e+00f, 4.403666027e-01f, 1.939227447e-01f, 8.539710029e-02f, 3.760603093e-02f, 1.656044008e-02f, 7.292664737e-03f, 3.211445995e-03f, 1.414213562e-03f, 6.227724219e-04f, 2.742481757e-04f, 1.207697374e-04f, 5.318295897e-05f, 2.341999896e-05f, 1.031338538e-05f, 4.541670481e-06f};
__device__ __forceinline__ void cast_row(const float* src, bf16_t* dst, float* rs, int lane) {
    float s = 0.f;
#pragma unroll
    for (int j = 0; j < 4; ++j) { const f32x4_t v = *(const f32x4_t*)(src + 256 * j + 4 * lane); s += (v[0] * v[0] + v[1] * v[1]) + (v[2] * v[2] + v[3] * v[3]);
        u32x2_t w; w.x = pg8::cvt_pk_bf16(v[0], v[1]); w.y = pg8::cvt_pk_bf16(v[2], v[3]); *(u32x2_t*)(dst + 256 * j + 4 * lane) = w; }
    const float r = 1.0f / sqrtf(wave_sum(s) * (1.0f / DM) + NORM_EPS);
    if (lane == 0) *rs = r;
}
__device__ __forceinline__ int orig16(int p) { return (p & 3) | ((p & 4) << 1) | ((p & 8) >> 1); }
__device__ __forceinline__ int origkr(int p) { return (p & 3) + 4 * (p >> 3) + 16 * ((p >> 2) & 1); }
constexpr int N_WKINDS = 9;
__device__ __forceinline__ int witems(int kind) {
    return kind == 0 ? 16 * 88 : kind == 1 ? 16 * 32 : kind == 2 ? 16 * 8 : kind == 3 ? 16 * 16 : kind == 4 ? 4 * 32 : kind == 5 ? 16 * 176 : kind == 6 ? 44 * 32 : kind == 7 ? 4 * 16 : 2 * 16;
}
__device__ __forceinline__ void wmap(int kind, int n, int& src, float& scale, bool& second) {
    src = n; scale = 1.f; second = false;
    if (kind == 0) {
        if (n >= DIN) { src = -1; return; }
        const bool qsec = (n < 512) || (n >= 1536 && n < 1792);
        const bool ropesec = (n < 1024) || (n >= 1536 && n < 2048);
        if (qsec) scale = 0.125f * LOG2E;
        if (ropesec && (n & 63) < 16) src = (n & ~15) | orig16(n & 15);
        if (n >= 2688) src = 2688 + origkr(n - 2688);
    } else if (kind == 2) { scale = 0.125f * LOG2E; }
    else if (kind == 5) { const int t = n >> 8, bj = (n >> 7) & 1, j = n & 127; src = t * 128 + j; second = (bj != 0); }
    else if (kind == 7) {
        if (n >= 384) { src = -1; return; }
        const int h = n / 96, w = n - 96 * h; src = 96 * h + (w < 64 ? w : 64 + origkr(w - 64)); scale = 0.10206207261596575f * LOG2E;
    }
}
__device__ __forceinline__ void prep_item(const Frame& F, int l, int kind, int item, LAS float* scr, int lane) {
    const float* g = F.gains() + (size_t)l * 7 * DM;
    const float* W; const float* W2 = nullptr; const float* gain = nullptr; bf16_t* dst; int K, Nsrc, Ndst;
    if (kind == 0)      { W = F.w_in() + (size_t)l * DM * DIN; gain = g; dst = wptr(F, l, W_IN); K = DM; Nsrc = DIN; Ndst = QKV_LD; }
    else if (kind == 1) { W = F.w_out() + (size_t)l * DM * DM; dst = wptr(F, l, W_OUT); K = DM; Nsrc = DM; Ndst = DM; }
    else if (kind == 2) { W = F.w_mq() + (size_t)l * DM * 256; gain = g + 2 * DM; dst = wptr(F, l, W_MQ); K = DM; Nsrc = 256; Ndst = 256; }
    else if (kind == 3) { W = F.w_mkv() + (size_t)l * DM * 512; gain = g + 3 * DM; dst = wptr(F, l, W_MKV); K = DM; Nsrc = 512; Ndst = 512; }
    else if (kind == 4) { W = F.w_mo() + (size_t)l * 256 * DM; dst = wptr(F, l, W_MO); K = 256; Nsrc = DM; Ndst = DM; }
    else if (kind == 5) { W = F.w_gate() + (size_t)l * DM * DFF; W2 = F.w_up() + (size_t)l * DM * DFF; gain = g + 5 * DM; dst = wptr(F, l, W_GU); K = DM; Nsrc = DFF; Ndst = 2 * DFF; }
    else if (kind == 6) { W = F.w_down() + (size_t)l * DFF * DM; dst = wptr(F, l, W_DN); K = DFF; Nsrc = DM; Ndst = DM; }
    else if (kind == 7) { W = F.w_qup() + (size_t)l * 256 * 384; gain = F.qnorm() + l * 256; dst = wptr(F, l, W_QUP); K = 256; Nsrc = 384; Ndst = 512; }
    else                { W = F.w_kvup() + (size_t)l * 128 * 512; gain = F.kvnorm() + l * 128; dst = wptr(F, l, W_KVUP); K = 128; Nsrc = 512; Ndst = 512; }
    const int nblk = Ndst / 32, kb = item / nblk, nb = item % nblk, k0 = 64 * kb, n0 = 32 * nb;
    int src; float scale; bool second; wmap(kind, n0 + (lane & 31), src, scale, second);
    if (second) W = W2;
#pragma unroll 8
    for (int i = 0; i < 32; ++i) { const int kk = 2 * i + (lane >> 5); float v = 0.f;
        if (src >= 0) { v = W[(size_t)(k0 + kk) * Nsrc + src] * scale; if (gain) v *= gain[k0 + kk]; }
        scr[kk * 33 + (lane & 31)] = v; }
    asm volatile("s_waitcnt lgkmcnt(0)" ::: "memory");
    const int c = lane & 7;
#pragma unroll
    for (int j = 0; j < 4; ++j) { const int n = (lane >> 3) + 8 * j; const LAS float* s = scr + (8 * c) * 33 + n;
        pg8::u32x4 o4; o4.x = pg8::cvt_pk_bf16(s[0 * 33], s[1 * 33]); o4.y = pg8::cvt_pk_bf16(s[2 * 33], s[3 * 33]); o4.z = pg8::cvt_pk_bf16(s[4 * 33], s[5 * 33]); o4.w = pg8::cvt_pk_bf16(s[6 * 33], s[7 * 33]);
        *(pg8::u32x4*)(dst + (size_t)(n0 + n) * K + k0 + 8 * c) = o4; }
    asm volatile("s_waitcnt lgkmcnt(0)" ::: "memory");
}
__device__ __forceinline__ void prologue(const Frame& F) {
    LAS float* scr = (LAS float*)(F.lds + F.wave * 16384);
    const int gw = blockIdx.x * NWAVES + F.wave, NGW = F.G * NWAVES;
    int per_layer = 0;
#pragma unroll
    for (int k = 0; k < N_WKINDS; ++k) per_layer += witems(k);
    for (int it = gw; it < 2 * per_layer; it += NGW) {
        const int l = it / per_layer; int r = it - l * per_layer, kind = 0;
        while (r >= witems(kind)) { r -= witems(kind); ++kind; }
        prep_item(F, l, kind, r, scr, F.lane);
    }
    for (int m = gw; m < MTOK; m += NGW) cast_row(F.x() + (size_t)m * DM, F.XB() + (size_t)m * DM, F.RS() + m, F.lane);
    for (int m = gw; m < MEMTOK; m += NGW) norm_row(F.mem() + (size_t)m * DM, F.MEMN() + (size_t)m * DM, F.lane);
    const int gt = blockIdx.x * (NWAVES * 64) + F.tid, NGT = F.G * NWAVES * 64;
    for (int i = gt; i < MTOK * 24; i += NGT) {
        const int row = i / 24, f = i - row * 24;
        const float p = (float)F.pos()[row];
        const float inv = ROPE_INV[f];
        const float ang = p * inv;
        const double t = (double)ang * 0.15915494309189535; const float fr = (float)(t - rint(t));
        const float cs = __builtin_amdgcn_cosf(fr), sn = __builtin_amdgcn_sinf(fr);
        if (f < 8) { F.ropeP()[(size_t)row * 16 + f] = cs; F.ropeP()[(size_t)row * 16 + 8 + f] = sn; }
        else { const int ff = f - 8; F.ropeC()[(size_t)row * 32 + ff] = cs; F.ropeC()[(size_t)row * 32 + 16 + ff] = sn; }
    }
    if (blockIdx.x == 0 && F.tid < 2) {
        const int l = F.tid; const float* lv = F.dlam() + l * 4 * 64; float s01 = 0.f, s23 = 0.f;
        for (int i = 0; i < 64; ++i) { s01 += lv[i] * lv[64 + i]; s23 += lv[128 + i] * lv[192 + i]; }
        const float lam_init = 0.8f - 0.6f * expf(-0.3f * (float)l);
        F.misc()[l] = expf(s01) - expf(s23) + lam_init; F.misc()[2 + l] = 1.0f - lam_init;
    }
}

constexpr int N_PHASES = 3 + 12 * DEPTH;
constexpr int ATT_LDS_MAX = att::PassLay<64, 0, 128>::TOTAL;
static_assert(ATT_LDS_MAX <= 131072 && att::PassLay<64, 32, 64>::TOTAL <= 131072, "attention LDS");

__global__ void __launch_bounds__(NWAVES * 64, 2) mk_fwd(Args args) {
    extern __shared__ __attribute__((aligned(16))) unsigned char lds_raw[];
    cg::grid_group grid = cg::this_grid();
    Frame F;
    F.lds = (LAS unsigned char*)lds_raw;
    F.tid = threadIdx.x; F.lane = F.tid & 63; F.wave = __builtin_amdgcn_readfirstlane(F.tid >> 6);
    F.G = gridDim.x; { const int bx = blockIdx.x; F.vcu = (F.G % 8 == 0) ? (bx % 8) * (F.G / 8) + bx / 8 : bx; }
    const __attribute__((address_space(4))) Args* ap = (const __attribute__((address_space(4))) Args*)__builtin_amdgcn_kernarg_segment_ptr();
    F.a = ap;
    unsigned char* ws = F.ws();

    volatile LAS unsigned* misc_lds = (volatile LAS unsigned*)(F.lds + 131072);
    for (int u = F.tid; u < 64; u += NWAVES * 64) misc_lds[u] = 0u;
    __syncthreads();
    XcdBarrier bar = xcd_barrier_post((unsigned*)(ws + WS_CTL) + 4096, misc_lds + 8);

    int ph = args.ph_lo, rep = 0;
    while (ph < args.ph_hi) {
        { int t_ = threadIdx.x; asm volatile("" : "+v"(t_)); F.tid = t_; F.lane = t_ & 63; F.wave = __builtin_amdgcn_readfirstlane(t_ >> 6); const __attribute__((address_space(4))) Args* a_ = ap; asm volatile("" : "+s"(a_)); F.a = a_; }
        int l = 0, k = -1;
        if (ph == 0) k = -1; else if (ph <= 2) { k = -2; l = ph - 1; } else { l = (ph - 3) / 12; k = (ph - 3) % 12; }
#ifndef PROBE_MASK
#define PROBE_MASK 0
#endif
        const int nrep = (k >= 0 && ((PROBE_MASK >> k) & 1)) ? 2 : 1;
        if (k == -1) {
#ifndef NO_PRO
            prologue(F);
#endif
        } else if (k == -2 || k == 3 || k == 5 || k == 7 || k == 10) {
            pg8::Gemm g; pg8::EpiPlain E; int c = (int)blockIdx.x;
            if (k == -2) { g = pg8::Gemm{F.MEMN(), wptr(F, l, W_MKV), MEMTOK, 512, DM, DM}; E = pg8::EpiPlain{F.MKV() + (size_t)l * MEMTOK * 512, 512, nullptr}; c = (c + 128 * l) % F.G; }
            else if (k == 3) { g = pg8::Gemm{F.MIX(), wptr(F, l, W_OUT), MTOK, DM, DM, DM}; E = pg8::EpiPlain{F.BR(), DM, nullptr}; }
            else if (k == 5) { g = pg8::Gemm{F.XB(), wptr(F, l, W_MQ), MTOK, 256, DM, DM}; E = pg8::EpiPlain{F.MQ(), 256, F.RS()}; }
            else if (k == 7) { g = pg8::Gemm{F.MO(), wptr(F, l, W_MO), MTOK, DM, 256, 256}; E = pg8::EpiPlain{F.BR(), DM, nullptr}; }
            else { g = pg8::Gemm{F.H(), wptr(F, l, W_DN), MTOK, DM, DFF, DFF}; E = pg8::EpiPlain{F.BR(), DM, nullptr}; }
            pg8::StaticOrder S; S.init(g.M, g.N, F.G, c);
#ifndef NO_PLAIN
            pg8::gemm_phase<pg8::EpiPlain, pg8::StaticOrder, true, true>(F.lds, g, S, E);
#endif
        } else if (k == 0) {
            pg8::Gemm g{F.XB(), wptr(F, l, W_IN), MTOK, QKV_LD, DM, DM}; pg8::StaticOrder S; S.init(MTOK, QKV_LD, F.G, (int)blockIdx.x);
            pg8::EpiQKV E{F.QKV(), F.ropeP(), F.ropeC(), F.cqssq(), F.ckvssq(), F.RS()};
#ifndef NO_QKV
            pg8::gemm_phase<pg8::EpiQKV, pg8::StaticOrder, true, true>(F.lds, g, S, E);
#endif
        } else if (k == 1) {
            int kq = 256, kkv = 128; asm volatile("" : "+s"(kq), "+s"(kkv));
            { pg8::Gemm g{F.QKV() + 2304, wptr(F, l, W_QUP), MTOK, 512, kq, QKV_LD}; pg8::StaticOrder S; S.init(MTOK, 512, F.G, (int)blockIdx.x);
              pg8::EpiMLA<true, 256> E{F.QC(), F.cqssq(), F.ropeC()};
#ifndef NO_MLA
              pg8::gemm_phase<pg8::EpiMLA<true, 256>, pg8::StaticOrder, true, true>(F.lds, g, S, E);
#endif
 }
            { pg8::Gemm g{F.QKV() + 2560, wptr(F, l, W_KVUP), MTOK, 512, kkv, QKV_LD}; pg8::StaticOrder S; S.init(MTOK, 512, F.G, (int)blockIdx.x);
              pg8::EpiMLA<false, 128> E{F.KVC(), F.ckvssq(), F.ropeC()};
#ifndef NO_MLA
              pg8::gemm_phase<pg8::EpiMLA<false, 128>, pg8::StaticOrder, true, true>(F.lds, g, S, E);
#endif
 }
        } else if (k == 2) {
#ifndef PROBE_SUB
#define PROBE_SUB 7
#endif
            const int sub = (rep + 1 < nrep) ? PROBE_SUB : 7;
#ifndef NO_A
            if (sub & 1) {
#pragma unroll 1
            for (int i = 0; i < 2; ++i) { const int u = 2 * F.vcu + i; unit_A(F, l, u >> 5, (u >> 3) & 3, u & 7); } }
#endif
#ifndef NO_C
            if (sub & 2) {
#pragma unroll 1
            for (int i = 0; i < 2; ++i) { const int u = 2 * F.vcu + i; unit_C(F, u >> 5, (u >> 3) & 3, u & 7); } }
#endif
            __syncthreads();
#ifndef NO_B
            if (sub & 4) {
#pragma unroll 1
            for (int i = 0; i < 2; ++i) { const int w = (F.vcu * NWAVES + F.wave) + 2048 * i; dil_unit(F, w >> 8, (w >> 6) & 3, (w >> 4) & 3, w & 15); } }
#endif
        } else if (k == 4 || k == 8 || k == 11) {
            const float* g = F.gains() + (size_t)l * 7 * DM + (k == 4 ? 1 : (k == 8 ? 4 : 6)) * DM;
#ifndef NO_ROW
            const bool last = (k == 11 && l == DEPTH - 1);
            if (rep + 1 < nrep) row_pass(F, F.XB(), F.BR(), g, F.MIX(), F.cqssq(), last ? (float*)F.QKV() : nullptr);
            else row_pass(F, F.XB(), F.BR(), g, F.XB(), F.RS(), last ? F.out() : nullptr);
#endif
        } else if (k == 6) {
#ifndef NO_M
#pragma unroll 1
            for (int i = 0; i < 2; ++i) { const int u = 2 * F.vcu + i; unit_M(F, l, u >> 5, (u >> 3) & 3, u & 7); }
#endif
        } else if (k == 9) {
            pg8::Gemm g{F.XB(), wptr(F, l, W_GU), MTOK, 2 * DFF, DM, DM}; pg8::StaticOrder S; S.init(MTOK, 2 * DFF, F.G, (int)blockIdx.x);
            pg8::EpiSwiGLU E{F.H(), F.RS()};
#ifndef NO_GU
            pg8::gemm_phase<pg8::EpiSwiGLU, pg8::StaticOrder, true, true>(F.lds, g, S, E);
#endif
        }
        if (rep + 1 < nrep) { xcd_barrier(bar); ++rep; continue; }
        if (ph + 1 < args.ph_hi && !(ph == 1 || ph == 2)) {
            if (ph == 0) { __threadfence(); grid.sync(); } else xcd_barrier(bar);
        }
        ++ph; rep = 0;
    }
}

extern "C" void kernel_launch(void* const* d_in, const int* in_sizes, int n_in, void* d_out, int out_size, void* d_ws, size_t ws_size, hipStream_t stream) {
    static int grid = 0;
    if (grid == 0) {
        int dev = 0, cus = 0, per_cu = 0;
        if (n_in != 18 || in_sizes[0] != MTOK * DM || out_size != MTOK * DM || ws_size < WS_END) {
            fprintf(stderr, "kernel_launch: unexpected shapes / workspace (n_in %d, ws %zu < %zu?)\n", n_in, ws_size, (size_t)WS_END); grid = -1; return; }
        (void)hipGetDevice(&dev);
        (void)hipDeviceGetAttribute(&cus, hipDeviceAttributeMultiprocessorCount, dev);
        (void)hipFuncSetAttribute((const void*)mk_fwd, hipFuncAttributeMaxDynamicSharedMemorySize, LDS_BYTES);
        (void)hipOccupancyMaxActiveBlocksPerMultiprocessor(&per_cu, (const void*)mk_fwd, NWAVES * 64, LDS_BYTES);
        (void)hipGetLastError();
        grid = cus;
        if (per_cu < 1) fprintf(stderr, "kernel_launch: occupancy query says %d blocks per CU\n", per_cu);
    }
    if (grid < 0) return;
    (void)hipMemsetAsync((char*)d_ws + WS_CTL, 0, CTL_ZERO_BYTES, stream);
    Args a{};
    for (int i = 0; i < 18; ++i) a.in[i] = d_in[i];
    a.out = (float*)d_out; a.ws = (unsigned char*)d_ws;
#ifdef MK_SPLIT
    for (int ph = 0; ph < N_PHASES; ++ph) {
        if (ph == 1 || ph == 2) continue;
        a.ph_lo = (ph == 3) ? 1 : ph; a.ph_hi = ph + 1;
        void* kargs[] = {&a};
        hipError_t e = hipLaunchCooperativeKernel((const void*)mk_fwd, dim3(grid), dim3(NWAVES * 64), kargs, LDS_BYTES, stream);
        if (e != hipSuccess) { fprintf(stderr, "cooperative launch failed: %s (grid %d)\n", hipGetErrorString(e), grid); break; }
    }
#else
    a.ph_lo = 0; a.ph_hi = N_PHASES;
    void* kargs[] = {&a};
    hipError_t e = hipLaunchCooperativeKernel((const void*)mk_fwd, dim3(grid), dim3(NWAVES * 64), kargs, LDS_BYTES, stream);
    if (e != hipSuccess) fprintf(stderr, "cooperative launch failed: %s (grid %d)\n", hipGetErrorString(e), grid);
#endif
}
```

```cpp
#include <hip/hip_runtime.h>
#include <hip/hip_cooperative_groups.h>
#include <cstdio>
#include <cstdint>
namespace cg = cooperative_groups;

#define LAS __attribute__((address_space(3)))
constexpr int NWAVES = 8;
constexpr int LDS_BYTES = 147456;
constexpr int BATCH = 16, SEQ = 2048, DM = 1024, MTOK = BATCH * SEQ, DEPTH = 2;
constexpr int DIN = 2720, QKV_LD = 2816, DFF = 2816, MEML = 256, MEMTOK = BATCH * MEML;
constexpr float NORM_EPS = 1e-6f;
constexpr float LOG2E = 1.4426950408889634f;

#define XB_TMO      128
#define XB_XCNT(j)  (256  + 64 * (j))
#define XB_XSUB(j)  (1280 + 64 * (j))
#define XB_XGEN(j)  (2304 + 64 * (j))
#define XB_TOP      3328
#define XB_TOPGEN   3392
#define XCD_BAR_WORDS 3456
#define XB_SPIN_CAP (1u << 18)
__device__ __forceinline__ unsigned xb_ld(unsigned* p)              { return __hip_atomic_load(p, __ATOMIC_RELAXED, __HIP_MEMORY_SCOPE_AGENT); }
__device__ __forceinline__ unsigned xb_add(unsigned* p, unsigned v) { return __hip_atomic_fetch_add(p, v, __ATOMIC_RELAXED, __HIP_MEMORY_SCOPE_AGENT); }
__device__ __forceinline__ unsigned xb_xcc_id() { return (unsigned)__builtin_amdgcn_s_getreg((3 << 11) | 20) & 0xFu; }
#define XB_SPIN(cond, bar) do { unsigned _sp = 0; while (cond) { __builtin_amdgcn_s_sleep(1); \
    if ((++_sp & 255u) == 0u) { if (xb_ld(&(bar)[XB_TMO])) break; if (_sp > XB_SPIN_CAP) { atomicAdd(&(bar)[XB_TMO], 1u); break; } } } } while (0)
struct XcdBarrier { unsigned* bar; unsigned x; volatile LAS unsigned* st; };
__device__ __forceinline__ XcdBarrier xcd_barrier_post(unsigned* bar, volatile LAS unsigned* st) {
    XcdBarrier b; b.bar = bar; b.x = xb_xcc_id(); b.st = st;
    if (threadIdx.x == 0) (void)xb_add(&bar[XB_XCNT(b.x)], 1u);
    return b;
}
__device__ __forceinline__ void xcd_barrier_complete(unsigned* bar, unsigned x, unsigned& nloc, unsigned& nx) {
    const unsigned G = gridDim.x * gridDim.y * gridDim.z;
    unsigned sum, cnt, mine, sp = 0u;
    for (;;) {
        sum = 0u; cnt = 0u; mine = 0u;
#pragma unroll
        for (unsigned j = 0; j < 16; ++j) { const unsigned c = xb_ld(&bar[XB_XCNT(j)]); sum += c; cnt += (c > 0u) ? 1u : 0u; mine = (j == x) ? c : mine; }
        if (sum == G) break;
        __builtin_amdgcn_s_sleep(1);
        if ((++sp & 255u) == 0u) { if (xb_ld(&bar[XB_TMO])) break; if (sp > XB_SPIN_CAP) { atomicAdd(&bar[XB_TMO], 1u); break; } }
    }
    nloc = mine > 0u ? mine : 1u; nx = cnt > 0u ? cnt : 1u;
}
__device__ __forceinline__ void xcd_barrier(const XcdBarrier& b) {
    asm volatile("s_waitcnt vmcnt(0)" ::: "memory");
    __syncthreads();
    if (threadIdx.x == 0) {
        unsigned* bar = b.bar;
        __builtin_amdgcn_s_waitcnt(0);
        unsigned nloc = b.st[0], nx = b.st[1];
        if (nloc == 0u) { xcd_barrier_complete(bar, b.x, nloc, nx); b.st[0] = nloc; b.st[1] = nx; }
        const unsigned old = xb_add(&bar[XB_XSUB(b.x)], 1u);
        const unsigned gen = old / nloc;
        if (old + 1u == (gen + 1u) * nloc) {
            __builtin_amdgcn_fence(__ATOMIC_RELEASE, "agent");
            asm volatile("s_waitcnt vmcnt(0)" ::: "memory");
            const unsigned og = xb_add(&bar[XB_TOP], 1u);
            const unsigned tg = og / nx;
            if (og + 1u == (tg + 1u) * nx) xb_add(&bar[XB_TOPGEN], 1u);
            else XB_SPIN(xb_ld(&bar[XB_TOPGEN]) == tg, bar);
            __builtin_amdgcn_fence(__ATOMIC_ACQUIRE, "agent");
            xb_add(&bar[XB_XGEN(b.x)], 1u);
            asm volatile("s_waitcnt vmcnt(0)" ::: "memory");
        } else {
            XB_SPIN(xb_ld(&bar[XB_XGEN(b.x)]) == gen, bar);
            __builtin_amdgcn_fence(__ATOMIC_ACQUIRE, "agent");
            asm volatile("s_waitcnt vmcnt(0)" ::: "memory");
        }
    }
    __syncthreads();
}

namespace pg8 {
#define PG8_LAS __attribute__((address_space(3)))
typedef unsigned short bf16_t;
typedef short bf16x8 __attribute__((ext_vector_type(8)));
typedef float f32x4 __attribute__((ext_vector_type(4)));
typedef unsigned u32x4 __attribute__((ext_vector_type(4)));
constexpr int BM = 256, BK = 64, HALF = 128, HTB = HALF * BK * 2  , STAGE_BYTES = 8 * HTB, NXCD = 8, WGM = 8;

__host__ __device__ __forceinline__ int lds_byte(int r, int c) { const int st = (r >> 4) * 2 + (c >> 5), rr = r & 15, cc = c & 31, ob = rr * 64 + cc * 2; return st * 1024 + (ob ^ (((ob >> 9) & 1) << 5)); }
__host__ __device__ __forceinline__ void stage_rc(int b, int& R, int& C) { const int st = b / 1024, sb = b % 1024, swz = sb ^ (((sb >> 9) & 1) << 5); R = (st >> 1) * 16 + swz / 64; C = (st & 1) * 32 + (swz % 64) / 2; }
__host__ __device__ __forceinline__ int perm32(int rho) { const int n = rho >> 4, i = rho & 15; return 8 * (i >> 2) + 4 * n + (i & 3); }

struct Unit { int pm, pn; };
struct Gemm { const bf16_t* A; const bf16_t* Bt; int M, N, K, lda; };

struct StaticOrder {
    int nM, nN, nwg, G, c;
    __host__ __device__ void init(int M, int N, int G_, int c_) { nM = M / BM; nN = N / BM; nwg = nM * nN; G = G_; c = c_; }
    __host__ __device__ bool next(int i, Unit& u) const {
        const long L = (long)i * G + c; if (L >= nwg) return false;
        int wgid = (int)L; { const int q = nwg / NXCD, r = nwg % NXCD, xcd = wgid % NXCD, off = wgid / NXCD; wgid = (xcd < r ? xcd * (q + 1) : r * (q + 1) + (xcd - r) * q) + off; }
        const int nig = WGM * nN, gid = wgid / nig, fm = gid * WGM, gsz = (nM - fm) < WGM ? (nM - fm) : WGM;
        u.pm = fm + ((wgid % nig) % gsz); u.pn = (wgid % nig) / gsz; return true;
    }
    __device__ __forceinline__ void a_ready(const Unit&) const {}
    __device__ __forceinline__ void done(const Unit&) const {}
};

template <class Epi, class Sched, bool ALIGN_EPI = false, bool SP2 = false>
__device__ __forceinline__ void gemm_phase(PG8_LAS unsigned char* lds, const Gemm g, const Sched& S, const Epi& E) {
    int tid_ = threadIdx.x; asm volatile("" : "+v"(tid_));
    const int tid = tid_, wid = __builtin_amdgcn_readfirstlane(tid >> 6), lane = tid & 63, wr = wid >> 2, wc = wid & 3, fr = lane & 15, fq = lane >> 4;
    const int K = g.K, nt = K / BK;
    unsigned voffA[2], voffB[2];
#pragma unroll
    for (int i = 0; i < 2; ++i) { int R, C; stage_rc(tid * 16 + i * 8192, R, C); const int Rb = Epi::PERM ? ((R & ~31) + perm32(R & 31)) : R;
        voffA[i] = (unsigned)(R * g.lda + C) * 2u; voffB[i] = (unsigned)(Rb * K + C) * 2u; }
    const size_t kstep = (size_t)(BK * 2);
    const size_t hstepA = (size_t)HALF * g.lda * 2, hstepB = (size_t)HALF * K * 2;
    const size_t tstepA = 2 * hstepA, tstepB = 2 * hstepB;
    const unsigned ldsw = (unsigned)wid * 1024u;
    const int aoff = lds_byte(wr * 64 + fr, fq * 8), boff = lds_byte(wc * 32 + fr, fq * 8);
#define PG8_SA(b, h) (((b) * 2 + (h)) * HTB)
#define PG8_SB(b, h) ((4 + (b) * 2 + (h)) * HTB)
#define PG8_STAGE(bufoff, gbase, voff) do { _Pragma("unroll") for (int _i = 0; _i < 2; ++_i) \
        __builtin_amdgcn_global_load_lds((const unsigned*)((const char*)(gbase) + (voff)[_i]), (PG8_LAS unsigned*)(lds + (bufoff) + ldsw + _i * 8192), 16, 0, 0); } while (0)
#define PG8_LDA(dst, b, h) do { _Pragma("unroll") for (int m = 0; m < 4; ++m) _Pragma("unroll") for (int k = 0; k < 2; ++k) dst[m][k] = *(const PG8_LAS bf16x8*)(lds + PG8_SA(b, h) + aoff + m * 2048 + k * 1024); } while (0)
#define PG8_LDB(dst, b, h) do { _Pragma("unroll") for (int n = 0; n < 2; ++n) _Pragma("unroll") for (int k = 0; k < 2; ++k) dst[n][k] = *(const PG8_LAS bf16x8*)(lds + PG8_SB(b, h) + boff + n * 2048 + k * 1024); } while (0)
#define PG8_MMA(ai, bj, At, Bt) do { __builtin_amdgcn_s_setprio(1); _Pragma("unroll") for (int m = 0; m < 4; ++m) _Pragma("unroll") for (int n = 0; n < 2; ++n) _Pragma("unroll") for (int k = 0; k < 2; ++k) \
        acc[ai][bj][m][n] = __builtin_amdgcn_mfma_f32_16x16x32_bf16(Bt[n][k], At[m][k], acc[ai][bj][m][n], 0, 0, 0); __builtin_amdgcn_s_setprio(0); } while (0)
#define PG8_WAIT_V(n) asm volatile("s_waitcnt vmcnt(" #n ")" ::: "memory")
#define PG8_WAIT_L(n) asm volatile("s_waitcnt lgkmcnt(" #n ")" ::: "memory")
#define PG8_BAR __builtin_amdgcn_s_barrier()
#define PG8_SCHED __builtin_amdgcn_sched_barrier(0)
    Unit cur, nxt; int ui = 0;
    if (!S.next(0, cur)) return;
    f32x4 acc[2][2][4][2];
#pragma unroll
    for (int a = 0; a < 2; ++a)
#pragma unroll
        for (int b = 0; b < 2; ++b)
#pragma unroll
            for (int m = 0; m < 4; ++m)
#pragma unroll
                for (int n = 0; n < 2; ++n) acc[a][b][m][n] = (f32x4){0.f, 0.f, 0.f, 0.f};
    bf16x8 At[4][2], B0[2][2], B1[2][2];
    const char* cA = (const char*)g.A + (size_t)cur.pm * tstepA; const char* cB = (const char*)g.Bt + (size_t)cur.pn * tstepB;
    S.a_ready(cur);
    if constexpr (SP2) {
        PG8_STAGE(PG8_SB(0, 0), cB, voffB); PG8_STAGE(PG8_SB(0, 1), cB + hstepB, voffB); PG8_STAGE(PG8_SA(0, 0), cA, voffA); PG8_STAGE(PG8_SA(0, 1), cA + hstepA, voffA);
        if (wr == 1) PG8_BAR;
        PG8_WAIT_V(2); PG8_BAR;
        PG8_STAGE(PG8_SB(1, 0), cB + kstep, voffB); PG8_STAGE(PG8_SA(1, 0), cA + kstep, voffA); PG8_STAGE(PG8_SB(1, 1), cB + hstepB + kstep, voffB);
        PG8_WAIT_V(6); PG8_BAR;
    } else {
        PG8_STAGE(PG8_SB(0, 0), cB, voffB); PG8_STAGE(PG8_SA(0, 0), cA, voffA); PG8_STAGE(PG8_SB(0, 1), cB + hstepB, voffB); PG8_STAGE(PG8_SA(0, 1), cA + hstepA, voffA);
        if (wr == 1) PG8_BAR;
        PG8_WAIT_V(4); PG8_BAR;
        PG8_STAGE(PG8_SB(1, 0), cB + kstep, voffB); PG8_STAGE(PG8_SA(1, 0), cA + kstep, voffA); PG8_STAGE(PG8_SB(1, 1), cB + hstepB + kstep, voffB);
        PG8_WAIT_V(6); PG8_BAR;
    }
    for (;;) {
        const bool has_next = S.next(ui + 1, nxt);
        const char* nA = has_next ? (const char*)g.A + (size_t)nxt.pm * tstepA : cA; const char* nB = has_next ? (const char*)g.Bt + (size_t)nxt.pn * tstepB : cB;
        for (int t = 0; t < nt; t += 2) {
            const bool last = (t == nt - 2);
            const char* a1 = cA + (size_t)(t + 1) * kstep;
            const char* a2 = last ? nA : cA + (size_t)(t + 2) * kstep; const char* b2 = last ? nB : cB + (size_t)(t + 2) * kstep;
            const char* a3 = a2 + kstep; const char* b3 = b2 + kstep;
            if (last && has_next) S.a_ready(nxt);
            if constexpr (SP2) {
            PG8_LDB(B0, 0, 0); PG8_LDB(B1, 0, 1); PG8_SCHED; PG8_LDA(At, 0, 0); PG8_STAGE(PG8_SA(1, 1), a1 + hstepA, voffA);
            PG8_WAIT_V(8); PG8_WAIT_L(0); PG8_BAR; PG8_MMA(0, 0, At, B0); PG8_MMA(0, 1, At, B1); PG8_BAR; PG8_SCHED;
            PG8_LDA(At, 0, 1); PG8_STAGE(PG8_SB(0, 0), b2, voffB); PG8_STAGE(PG8_SB(0, 1), b2 + hstepB, voffB); PG8_STAGE(PG8_SA(0, 0), a2, voffA);
            PG8_WAIT_V(8); PG8_WAIT_L(0); PG8_BAR; PG8_MMA(1, 0, At, B0); PG8_MMA(1, 1, At, B1); PG8_BAR; PG8_SCHED;
            PG8_LDB(B0, 1, 0); PG8_LDB(B1, 1, 1); PG8_SCHED; PG8_LDA(At, 1, 0); PG8_STAGE(PG8_SA(0, 1), a2 + hstepA, voffA);
            PG8_WAIT_V(8); PG8_WAIT_L(0); PG8_BAR; PG8_MMA(0, 0, At, B0); PG8_MMA(0, 1, At, B1); PG8_BAR; PG8_SCHED;
            PG8_LDA(At, 1, 1); PG8_STAGE(PG8_SB(1, 0), b3, voffB); PG8_STAGE(PG8_SB(1, 1), b3 + hstepB, voffB); PG8_STAGE(PG8_SA(1, 0), a3, voffA);
            PG8_WAIT_V(8); PG8_WAIT_L(0); PG8_BAR; PG8_MMA(1, 0, At, B0); PG8_MMA(1, 1, At, B1); PG8_BAR; PG8_SCHED;
            } else {
            PG8_LDB(B0, 0, 0); PG8_SCHED; PG8_LDA(At, 0, 0); PG8_STAGE(PG8_SA(1, 1), a1 + hstepA, voffA);
            PG8_WAIT_L(8); PG8_BAR; PG8_WAIT_L(0); PG8_MMA(0, 0, At, B0); PG8_BAR; PG8_SCHED;
            PG8_LDB(B1, 0, 1); PG8_STAGE(PG8_SB(0, 0), b2, voffB);
            PG8_BAR; PG8_WAIT_L(0); PG8_MMA(0, 1, At, B1); PG8_BAR;
            PG8_LDA(At, 0, 1); PG8_STAGE(PG8_SA(0, 0), a2, voffA);
            PG8_BAR; PG8_WAIT_L(0); PG8_MMA(1, 0, At, B0); PG8_BAR; PG8_SCHED;
            PG8_STAGE(PG8_SB(0, 1), b2 + hstepB, voffB);
            PG8_WAIT_V(6); PG8_BAR; PG8_MMA(1, 1, At, B1); PG8_BAR;
            PG8_LDB(B0, 1, 0); PG8_SCHED; PG8_LDA(At, 1, 0); PG8_STAGE(PG8_SA(0, 1), a2 + hstepA, voffA);
            PG8_WAIT_L(8); PG8_BAR; PG8_WAIT_L(0); PG8_MMA(0, 0, At, B0); PG8_BAR; PG8_SCHED;
            PG8_LDB(B1, 1, 1); PG8_STAGE(PG8_SB(1, 0), b3, voffB);
            PG8_BAR; PG8_WAIT_L(0); PG8_MMA(0, 1, At, B1); PG8_BAR;
            PG8_LDA(At, 1, 1); PG8_STAGE(PG8_SA(1, 0), a3, voffA);
            PG8_BAR; PG8_WAIT_L(0); PG8_MMA(1, 0, At, B0); PG8_BAR; PG8_SCHED;
            PG8_STAGE(PG8_SB(1, 1), b3 + hstepB, voffB);
            PG8_WAIT_V(6); PG8_BAR; PG8_MMA(1, 1, At, B1); PG8_BAR;
            }
        }
        if constexpr (ALIGN_EPI) { if (wr == 0) PG8_BAR; }
        if constexpr (!Epi::AFTER_DRAIN) { E(acc, cur, wr, wc, fr, fq); S.done(cur); }
        if (!has_next) break;
#pragma unroll
        for (int a = 0; a < 2; ++a)
#pragma unroll
            for (int b = 0; b < 2; ++b)
#pragma unroll
                for (int m = 0; m < 4; ++m)
#pragma unroll
                    for (int n = 0; n < 2; ++n) acc[a][b][m][n] = (f32x4){0.f, 0.f, 0.f, 0.f};
        cur = nxt; cA = nA; cB = nB; ++ui;
        if constexpr (ALIGN_EPI) { if (wr == 1) PG8_BAR; }
    }
    PG8_WAIT_V(0);
    if constexpr (!ALIGN_EPI) { if (wr == 0) PG8_BAR; }
    PG8_BAR;
    if constexpr (Epi::AFTER_DRAIN) { E.fused(acc, cur, wr, wc, fr, fq, lds, wid, lane); S.done(cur); }
#undef PG8_SA
#undef PG8_SB
#undef PG8_STAGE
#undef PG8_LDA
#undef PG8_LDB
#undef PG8_MMA
#undef PG8_WAIT_V
#undef PG8_WAIT_L
#undef PG8_BAR
#undef PG8_SCHED
}
}

namespace pg8 {
__device__ __forceinline__ unsigned cvt_pk_bf16(float lo, float hi) { unsigned r; asm volatile("v_cvt_pk_bf16_f32 %0, %1, %2" : "=v"(r) : "v"(lo), "v"(hi)); return r; }
__device__ __forceinline__ void store8(bf16_t* p, const f32x4 v0, const f32x4 v1) {
    u32x4 w; w.x = cvt_pk_bf16(v0[0], v0[1]); w.y = cvt_pk_bf16(v0[2], v0[3]); w.z = cvt_pk_bf16(v1[0], v1[1]); w.w = cvt_pk_bf16(v1[2], v1[3]);
    *(u32x4*)p = w;
}
__device__ __forceinline__ void rot4(f32x4& a, f32x4& b, const f32x4 c, const f32x4 s) {
    const f32x4 x1 = a, x2 = b; a = x1 * c - x2 * s; b = x2 * c + x1 * s;
}
struct EpiPlain {
    static constexpr bool PERM = true, AFTER_DRAIN = false;
    bf16_t* O; int ldc; const float* rs;
    __device__ __forceinline__ void operator()(const f32x4 (&acc)[2][2][4][2], const Unit& u, int wr, int wc, int fr, int fq) const {
        const int row0 = u.pm * BM + wr * 64 + fr, col0 = u.pn * BM + wc * 32 + 8 * fq;
#pragma unroll
        for (int ai = 0; ai < 2; ++ai)
#pragma unroll
            for (int m = 0; m < 4; ++m) { const int row = row0 + ai * HALF + m * 16; bf16_t* rowp = O + (size_t)row * ldc + col0;
                const float sc = rs ? rs[row] : 1.0f;
#pragma unroll
                for (int bj = 0; bj < 2; ++bj) store8(rowp + bj * HALF, acc[ai][bj][m][0] * sc, acc[ai][bj][m][1] * sc);
                asm volatile("" ::: "memory"); }
    }
};
struct EpiQKV {
    static constexpr bool PERM = true, AFTER_DRAIN = false;
    bf16_t* O; const float* ropeP; const float* ropeC; float* cqssq; float* ckvssq; const float* rs;
    __device__ __forceinline__ void operator()(const f32x4 (&acc)[2][2][4][2], const Unit& u, int wr, int wc, int fr, int fq) const {
        const int pn = u.pn;
        const int row0 = u.pm * BM + wr * 64 + fr, col0 = pn * BM + wc * 32 + 8 * fq;
        const bool rope64 = ((pn < 4) || pn == 6 || pn == 7) && !(wc & 1) && (fq < 2);
        const bool ropekr = (pn == 10) && (wc == 0);
#pragma unroll
        for (int ai = 0; ai < 2; ++ai)
#pragma unroll
            for (int m = 0; m < 4; ++m) {
                const int row = row0 + ai * HALF + m * 16;
                f32x4 v[2][2];
#pragma unroll
                for (int bj = 0; bj < 2; ++bj) { v[bj][0] = acc[ai][bj][m][0] * rs[row]; v[bj][1] = acc[ai][bj][m][1] * rs[row]; }
                if (rope64) {
                    const f32x4 c = *(const f32x4*)(ropeP + (size_t)row * 16 + fq * 4), s = *(const f32x4*)(ropeP + (size_t)row * 16 + 8 + fq * 4);
                    rot4(v[0][0], v[0][1], c, s); rot4(v[1][0], v[1][1], c, s);
                }
                if (ropekr) {
                    const f32x4 c = *(const f32x4*)(ropeC + (size_t)row * 32 + fq * 4), s = *(const f32x4*)(ropeC + (size_t)row * 32 + 16 + fq * 4);
                    rot4(v[1][0], v[1][1], c, s);
                }
                if (pn == 9 || pn == 10) {
                    float ss = 0.f;
#pragma unroll
                    for (int e = 0; e < 4; ++e) ss += v[0][0][e] * v[0][0][e] + v[0][1][e] * v[0][1][e];
                    if (pn == 9) {
#pragma unroll
                        for (int e = 0; e < 4; ++e) ss += v[1][0][e] * v[1][0][e] + v[1][1][e] * v[1][1][e];
                    }
                    ss += __shfl_xor(ss, 16); ss += __shfl_xor(ss, 32);
                    if (fq == 0) { float* dst = (pn == 9) ? cqssq : ckvssq; dst[(size_t)row * 4 + wc] = ss; }
                }
                bf16_t* rowp = O + (size_t)row * QKV_LD + col0;
                store8(rowp, v[0][0], v[0][1]); store8(rowp + HALF, v[1][0], v[1][1]);
                asm volatile("" ::: "memory");
            }
    }
};
template <bool ROPE, int NCOLS> struct EpiMLA {
    static constexpr bool PERM = true, AFTER_DRAIN = false;
    bf16_t* O; const float* ssq; const float* ropeC;
    __device__ __forceinline__ void operator()(const f32x4 (&acc)[2][2][4][2], const Unit& u, int wr, int wc, int fr, int fq) const {
        const int row0 = u.pm * BM + wr * 64 + fr, col0 = u.pn * BM + wc * 32 + 8 * fq;
#pragma unroll
        for (int ai = 0; ai < 2; ++ai)
#pragma unroll
            for (int m = 0; m < 4; ++m) {
                const int row = row0 + ai * HALF + m * 16;
                const f32x4 p = *(const f32x4*)(ssq + (size_t)row * 4);
                const float rstd = __builtin_amdgcn_rsqf(((p[0] + p[1]) + (p[2] + p[3])) * (1.0f / NCOLS) + NORM_EPS);
#pragma unroll
                for (int bj = 0; bj < 2; ++bj) {
                    const int c0 = col0 + bj * HALF;
                    f32x4 v0 = acc[ai][bj][m][0] * rstd, v1 = acc[ai][bj][m][1] * rstd;
                    if (ROPE) { const int w = c0 % 96;
                        if (c0 < 384 && w >= 64) { const int f = (w - 64) >> 3;
                            const f32x4 c = *(const f32x4*)(ropeC + (size_t)row * 32 + f * 4), s = *(const f32x4*)(ropeC + (size_t)row * 32 + 16 + f * 4);
                            rot4(v0, v1, c, s); } }
                    store8(O + (size_t)row * 512 + c0, v0, v1);
                }
                asm volatile("" ::: "memory");
            }
    }
};
struct EpiSwiGLU {
    static constexpr bool PERM = true, AFTER_DRAIN = false;
    bf16_t* O; const float* rs;
    __device__ __forceinline__ void operator()(const f32x4 (&acc)[2][2][4][2], const Unit& u, int wr, int wc, int fr, int fq) const {
        const int row0 = u.pm * BM + wr * 64 + fr, col0 = u.pn * HALF + wc * 32 + 8 * fq;
#pragma unroll
        for (int ai = 0; ai < 2; ++ai)
#pragma unroll
            for (int m = 0; m < 4; ++m) {
                f32x4 hh[2]; const float sc = rs[row0 + ai * HALF + m * 16];
#pragma unroll
                for (int n = 0; n < 2; ++n) { const f32x4 g = acc[ai][0][m][n] * sc, uu = acc[ai][1][m][n] * sc;
#pragma unroll
                    for (int e = 0; e < 4; ++e) hh[n][e] = g[e] * uu[e] * __builtin_amdgcn_rcpf(1.0f + __builtin_amdgcn_exp2f(-g[e] * LOG2E)); }
                store8(O + (size_t)(row0 + ai * HALF + m * 16) * DFF + col0, hh[0], hh[1]);
                asm volatile("" ::: "memory");
            }
    }
};
}

typedef unsigned short bf16_t;
namespace att {
using bf16x8 = __attribute__((ext_vector_type(8))) short;
using s16x4  = __attribute__((ext_vector_type(4))) short;
using f32x16 = __attribute__((ext_vector_type(16))) float;
using u32x4  = __attribute__((ext_vector_type(4))) unsigned;
#define SBAR() __builtin_amdgcn_sched_barrier(0)
__device__ __forceinline__ int crow(int r, int hi) { return (r & 3) + 8 * (r >> 2) + 4 * hi; }
typedef float f32x2_t __attribute__((ext_vector_type(2))); typedef __bf16 bf16x2_t __attribute__((ext_vector_type(2)));
__device__ __forceinline__ unsigned cvtpk(float lo, float hi) { f32x2_t v = {lo, hi}; bf16x2_t b = __builtin_convertvector(v, bf16x2_t); return __builtin_bit_cast(unsigned, b); }
__device__ __forceinline__ unsigned short f2bf(float f) { unsigned u = __builtin_bit_cast(unsigned, f); return (unsigned short)((u + 0x7fffu + ((u >> 16) & 1u)) >> 16); }
__device__ __forceinline__ int ka_off(int row, int c) { return row * 128 + ((c ^ ((row >> 1) & 7)) << 4); }
__device__ __forceinline__ int kb_off(int row, int c) { return row * 64 + ((c ^ ((row >> 2) & 3)) << 4); }
template <int NCB> __device__ __forceinline__ int v_st(int k, int c) { const int kk = (k & ~0xC) | ((k & 4) << 1) | ((k & 8) >> 1); return ((kk >> 3) * NCB + (c >> 5)) * 512 + ((kk & 7) * 32 + (c & 31)) * 2; }
__device__ __forceinline__ int v_rd_base(int lane) { return ((lane & 3) << 3) | (((lane >> 2) & 3) << 6) | (((lane >> 4) & 1) << 5) | (((lane >> 5) & 1) << 8); }
template <int NCB> constexpr int v_rd_off(int d0, int ks, int half) { return d0 * 512 + ks * (2 * NCB * 512) + half * (NCB * 512); }
typedef short v4i16_t __attribute__((ext_vector_type(4)));
template <int OFF> __device__ __forceinline__ s16x4 tr_read(unsigned vb) {
    return __builtin_bit_cast(s16x4, __builtin_amdgcn_ds_read_tr16_b64_v4i16((LAS v4i16_t*)(uintptr_t)(vb + OFF)));
}
template <int D0, int NCB> __device__ __forceinline__ void pv_one(f32x16& od, unsigned vb, bf16x8 pa0, bf16x8 pa1, bf16x8 pa2, bf16x8 pa3) {
    const s16x4 l0 = tr_read<v_rd_off<NCB>(D0, 0, 0)>(vb), h0 = tr_read<v_rd_off<NCB>(D0, 0, 1)>(vb), l1 = tr_read<v_rd_off<NCB>(D0, 1, 0)>(vb), h1 = tr_read<v_rd_off<NCB>(D0, 1, 1)>(vb);
    const s16x4 l2 = tr_read<v_rd_off<NCB>(D0, 2, 0)>(vb), h2 = tr_read<v_rd_off<NCB>(D0, 2, 1)>(vb), l3 = tr_read<v_rd_off<NCB>(D0, 3, 0)>(vb), h3 = tr_read<v_rd_off<NCB>(D0, 3, 1)>(vb);
#define ATT_PK(L, H) (bf16x8){L[0], L[1], L[2], L[3], H[0], H[1], H[2], H[3]}
    od = __builtin_amdgcn_mfma_f32_32x32x16_bf16(pa0, ATT_PK(l0, h0), od, 0, 0, 0);
    od = __builtin_amdgcn_mfma_f32_32x32x16_bf16(pa1, ATT_PK(l1, h1), od, 0, 0, 0);
    od = __builtin_amdgcn_mfma_f32_32x32x16_bf16(pa2, ATT_PK(l2, h2), od, 0, 0, 0);
    od = __builtin_amdgcn_mfma_f32_32x32x16_bf16(pa3, ATT_PK(l3, h3), od, 0, 0, 0);
#undef ATT_PK
}
template <int NCB> __device__ __forceinline__ void pv_all(f32x16* o, unsigned vb, bf16x8 pa0, bf16x8 pa1, bf16x8 pa2, bf16x8 pa3) {
    pv_one<0, NCB>(o[0], vb, pa0, pa1, pa2, pa3); pv_one<1, NCB>(o[1], vb, pa0, pa1, pa2, pa3);
    if constexpr (NCB == 4) { pv_one<2, NCB>(o[2], vb, pa0, pa1, pa2, pa3); pv_one<3, NCB>(o[3], vb, pa0, pa1, pa2, pa3); }
}
constexpr float THR = 8.f;
__device__ __forceinline__ float rowmax32(const f32x16& p0, const f32x16& p1) {
    float pmax = p0[0];
#pragma unroll
    for (int r = 1; r < 16; ++r) pmax = fmaxf(pmax, p0[r]);
#pragma unroll
    for (int r = 0; r < 16; ++r) pmax = fmaxf(pmax, p1[r]);
    auto rr = __builtin_amdgcn_permlane32_swap(__float_as_uint(pmax), __float_as_uint(pmax), false, false);
    return fmaxf(__uint_as_float(rr[0]), __uint_as_float(rr[1]));
}
__device__ __forceinline__ void partialSM(f32x16& p0, f32x16& p1, float& m_reg, float& alpha) {
    const float pmax = rowmax32(p0, p1);
    const bool keep = __all(pmax - m_reg <= THR);
    const float mn = keep ? m_reg : fmaxf(m_reg, pmax);
    alpha = __builtin_amdgcn_exp2f(m_reg - mn); m_reg = mn;
#pragma unroll
    for (int r = 0; r < 16; ++r) { p0[r] -= mn; p1[r] -= mn; }
#pragma unroll
    for (int r = 0; r < 16; ++r) p0[r] = __builtin_amdgcn_exp2f(p0[r]);
}
#define ATT_PK4(P, BASE, OUT) do { unsigned a0 = cvtpk(P[BASE + 0], P[BASE + 1]), a1 = cvtpk(P[BASE + 2], P[BASE + 3]);   \
    unsigned b0 = cvtpk(P[BASE + 4], P[BASE + 5]), b1 = cvtpk(P[BASE + 6], P[BASE + 7]);                              \
    auto r0 = __builtin_amdgcn_permlane32_swap(a0, b0, false, false); auto r1 = __builtin_amdgcn_permlane32_swap(a1, b1, false, false); \
    u32x4 w = {r0[0], r1[0], r0[1], r1[1]}; OUT = __builtin_bit_cast(bf16x8, w); } while (0)
__device__ __forceinline__ void finishSM(f32x16& p0, f32x16& p1, float alpha, float& l_reg, bf16x8& pa0, bf16x8& pa1, bf16x8& pa2, bf16x8& pa3) {
#pragma unroll
    for (int r = 0; r < 16; ++r) p1[r] = __builtin_amdgcn_exp2f(p1[r]);
    float ps = 0;
#pragma unroll
    for (int r = 0; r < 16; ++r) ps += p0[r];
#pragma unroll
    for (int r = 0; r < 16; ++r) ps += p1[r];
    { auto rr = __builtin_amdgcn_permlane32_swap(__float_as_uint(ps), __float_as_uint(ps), false, false); ps = __uint_as_float(rr[0]) + __uint_as_float(rr[1]); }
    l_reg = l_reg * alpha + ps;
    ATT_PK4(p0, 0, pa0); ATT_PK4(p0, 8, pa1); ATT_PK4(p1, 0, pa2); ATT_PK4(p1, 8, pa3);
}
template <int NA, int NB> __device__ __forceinline__ void qkt(f32x16& p0, f32x16& p1, const LAS unsigned char* KAs, const LAS unsigned char* KBs, const bf16x8* qr, int r32, int hi) {
    p0 = f32x16{}; p1 = f32x16{};
#pragma unroll
    for (int d0 = 0; d0 < NA; ++d0) { const int o = ka_off(r32, d0 * 2 + hi);
        const bf16x8 b0 = *(const LAS bf16x8*)(KAs + o), b1 = *(const LAS bf16x8*)(KAs + o + 4096);
        p0 = __builtin_amdgcn_mfma_f32_32x32x16_bf16(b0, qr[d0], p0, 0, 0, 0);
        p1 = __builtin_amdgcn_mfma_f32_32x32x16_bf16(b1, qr[d0], p1, 0, 0, 0); }
#pragma unroll
    for (int d0 = 0; d0 < NB; ++d0) { const int o = kb_off(r32, d0 * 2 + hi);
        const bf16x8 b0 = *(const LAS bf16x8*)(KBs + o), b1 = *(const LAS bf16x8*)(KBs + o + 2048);
        p0 = __builtin_amdgcn_mfma_f32_32x32x16_bf16(b0, qr[NA + d0], p0, 0, 0, 0);
        p1 = __builtin_amdgcn_mfma_f32_32x32x16_bf16(b1, qr[NA + d0], p1, 0, 0, 0); }
}
template <int DQKA, int DQKB, int DV> struct PassLay {
    static constexpr int KAS = 64 * DQKA * 2, KBS = 64 * DQKB * 2, VS = 64 * DV * 2;
    static constexpr int KA_OFF = 0, KB_OFF = 3 * KAS, V_OFF = KB_OFF + 3 * KBS, WS_OFF = V_OFF + 3 * VS, TOTAL = WS_OFF + NWAVES * 256;
};
#define ATT_WAIT_BAR(N) asm volatile("s_waitcnt vmcnt(" #N ") lgkmcnt(0)\n\ts_barrier" ::: "memory")
template <int DQKA, int DQKB, int DV>
__device__ __forceinline__ void attn_pass(const bf16_t* __restrict__ Qrow, const bf16_t* __restrict__ KA, int ldka, const bf16_t* __restrict__ KB, int ldkb,
                                          const bf16_t* __restrict__ V, int ldv, int NT, LAS unsigned char* lds, f32x16 (&o)[DV / 32], float& l_out) {
    constexpr int NA = DQKA / 16, NB = DQKB / 16, NCB = DV / 32, NVC = DV / 64;
    static_assert(DQKA == 64 && (DQKB == 0 || DQKB == 32) && (DV == 64 || DV == 128), "shapes");
    using L = PassLay<DQKA, DQKB, DV>;
    int tid_ = threadIdx.x; asm volatile("" : "+v"(tid_));
    const int tid = tid_, wid = __builtin_amdgcn_readfirstlane(tid >> 6), lane = tid & 63, r32 = lane & 31, hi = lane >> 5;
    LAS float* al_l = (LAS float*)(lds + L::WS_OFF) + wid * 64 + 32;
    float m_reg = -1e30f, l_reg = 0.f;
#pragma unroll
    for (int d = 0; d < DV / 32; ++d) o[d] = f32x16{};
    bf16x8 qr[NA + NB];
#pragma unroll
    for (int d0 = 0; d0 < NA + NB; ++d0) qr[d0] = *(const bf16x8*)(Qrow + d0 * 16 + hi * 8);
    const int kar = 8 * wid + (lane >> 3);
    const bf16_t* kasrc = KA + (size_t)kar * ldka + (((lane & 7) ^ ((kar >> 1) & 7)) << 3);
    const int kbr = 16 * (wid & 3) + (lane >> 2);
    const bf16_t* kbsrc = KB + (size_t)kbr * ldkb + (((lane & 3) ^ ((kbr >> 2) & 3)) << 3);
    const bool kbon = (NB > 0) && (wid < 4);
    const bf16_t* vsrc[NVC];
#pragma unroll
    for (int j = 0; j < NVC; ++j) { const int p = NVC * wid + j, s = 2 * p + (lane >> 5), kg = s / NCB, cb = s % NCB, kk = kg * 8 + ((lane & 31) >> 2);
        const int k = (kk & ~0xC) | ((kk & 4) << 1) | ((kk & 8) >> 1);
        vsrc[j] = V + (size_t)k * ldv + cb * 32 + (lane & 3) * 8; }
    const size_t kastep = (size_t)64 * ldka, kbstep = (size_t)64 * ldkb, vstep = (size_t)64 * ldv;
#define ATT_DMA_K(t, slot) do { __builtin_amdgcn_global_load_lds((const unsigned*)(kasrc + (size_t)(t) * kastep), (LAS unsigned*)(lds + L::KA_OFF + (slot) * L::KAS + wid * 1024), 16, 0, 0); \
        if (kbon) __builtin_amdgcn_global_load_lds((const unsigned*)(kbsrc + (size_t)(t) * kbstep), (LAS unsigned*)(lds + L::KB_OFF + (slot) * L::KBS + (wid & 3) * 1024), 16, 0, 0); } while (0)
#define ATT_DMA_V(t, slot) do { _Pragma("unroll") for (int j_ = 0; j_ < NVC; ++j_) \
        __builtin_amdgcn_global_load_lds((const unsigned*)(vsrc[j_] + (size_t)(t) * vstep), (LAS unsigned*)(lds + L::V_OFF + (slot) * L::VS + (NVC * wid + j_) * 1024), 16, 0, 0); } while (0)
#define ATT_WAIT_STEADY() do { if (NB > 0) { if (wid < 4) { if (NVC == 2) ATT_WAIT_BAR(4); else ATT_WAIT_BAR(3); } else { if (NVC == 2) ATT_WAIT_BAR(3); else ATT_WAIT_BAR(2); } } \
        else { if (NVC == 2) ATT_WAIT_BAR(3); else ATT_WAIT_BAR(2); } } while (0)
#define ATT_SGB_QK() do { _Pragma("unroll") for (int i_ = 0; i_ < 2 * (NA + NB); ++i_) { __builtin_amdgcn_sched_group_barrier(0x100, 2, 0); __builtin_amdgcn_sched_group_barrier(0x008, 1, 0); __builtin_amdgcn_sched_group_barrier(0x002, (NA + NB == 4) ? 11 : 8, 0); } } while (0)
#define ATT_SGB_PV() do { _Pragma("unroll") for (int i_ = 0; i_ < 4 * NCB; ++i_) { __builtin_amdgcn_sched_group_barrier(0x100, 2, 0); __builtin_amdgcn_sched_group_barrier(0x008, 1, 0); __builtin_amdgcn_sched_group_barrier(0x002, (NCB == 4) ? 5 : 10, 0); } } while (0)
#define ATT_RESC(a) do { if (__any((a) < 1.f)) { if (hi == 0) al_l[r32] = (a); asm volatile("s_waitcnt lgkmcnt(0)" ::: "memory"); \
        _Pragma("unroll") for (int d = 0; d < DV / 32; ++d) _Pragma("unroll") for (int r = 0; r < 16; ++r) o[d][r] *= al_l[crow(r, hi)]; } } while (0)
    const unsigned vbase = (unsigned)(uintptr_t)lds + (unsigned)L::V_OFF + (unsigned)v_rd_base(lane);
    f32x16 pA0, pA1, pB0, pB1; float alA, alB; bf16x8 pa0, pa1, pa2, pa3;
    asm volatile("s_waitcnt vmcnt(0) lgkmcnt(0)\n\ts_barrier" ::: "memory");
    ATT_DMA_K(0, 0); ATT_DMA_K(1, 1); ATT_DMA_V(0, 0);
    ATT_DMA_K(2, 2); ATT_DMA_V(1, 1);
    ATT_WAIT_BAR(0);
    int ks = 0, vs = 0;
    qkt<NA, NB>(pA0, pA1, lds + L::KA_OFF, lds + L::KB_OFF, qr, r32, hi); partialSM(pA0, pA1, m_reg, alA);
    asm volatile("s_waitcnt lgkmcnt(0)\n\ts_barrier" ::: "memory");
    ks = 1; vs = 0;
    for (int t = 1; t + 1 < NT; t += 2) {
        { const int kn = ks == 0 ? 2 : ks - 1, vn = vs >= 1 ? vs - 1 : 2;
          ATT_DMA_K(t + 2 < NT ? t + 2 : NT - 1, kn); ATT_DMA_V(t + 1, vn); }
        SBAR(); qkt<NA, NB>(pB0, pB1, lds + L::KA_OFF + ks * L::KAS, lds + L::KB_OFF + ks * L::KBS, qr, r32, hi);
        finishSM(pA0, pA1, alA, l_reg, pa0, pa1, pa2, pa3); SBAR();
        pv_all<NCB>(o, vbase + vs * L::VS, pa0, pa1, pa2, pa3); partialSM(pB0, pB1, m_reg, alB);
        ATT_RESC(alB);
        ATT_WAIT_STEADY();
        ks = ks == 2 ? 0 : ks + 1; vs = vs == 2 ? 0 : vs + 1;
        { const int kn = ks == 0 ? 2 : ks - 1, vn = vs >= 1 ? vs - 1 : 2;
          ATT_DMA_K(t + 3 < NT ? t + 3 : NT - 1, kn); ATT_DMA_V(t + 2 < NT ? t + 2 : NT - 1, vn); }
        SBAR(); qkt<NA, NB>(pA0, pA1, lds + L::KA_OFF + ks * L::KAS, lds + L::KB_OFF + ks * L::KBS, qr, r32, hi);
        finishSM(pB0, pB1, alB, l_reg, pa0, pa1, pa2, pa3); SBAR();
        pv_all<NCB>(o, vbase + vs * L::VS, pa0, pa1, pa2, pa3); partialSM(pA0, pA1, m_reg, alA);
        ATT_RESC(alA);
        ATT_WAIT_STEADY();
        ks = ks == 2 ? 0 : ks + 1; vs = vs == 2 ? 0 : vs + 1;
    }
    asm volatile("s_waitcnt vmcnt(0)\n\ts_barrier" ::: "memory");
    SBAR(); qkt<NA, NB>(pB0, pB1, lds + L::KA_OFF + ks * L::KAS, lds + L::KB_OFF + ks * L::KBS, qr, r32, hi);
    finishSM(pA0, pA1, alA, l_reg, pa0, pa1, pa2, pa3); SBAR();
    pv_all<NCB>(o, vbase + vs * L::VS, pa0, pa1, pa2, pa3); partialSM(pB0, pB1, m_reg, alB);
    ATT_RESC(alB);
    vs = vs == 2 ? 0 : vs + 1;
    finishSM(pB0, pB1, alB, l_reg, pa0, pa1, pa2, pa3); SBAR();
    pv_all<NCB>(o, vbase + vs * L::VS, pa0, pa1, pa2, pa3);
    l_out = l_reg;
#undef ATT_DMA_K
#undef ATT_DMA_V
#undef ATT_WAIT_STEADY
#undef ATT_RESC
#undef ATT_SGB_QK
#undef ATT_SGB_PV
}
__device__ __forceinline__ void row_recip(float l_reg, LAS float* ws, int r32, int hi, float (&rli)[16]) {
    if (hi == 0) ws[r32] = l_reg;
    asm volatile("s_waitcnt lgkmcnt(0)" ::: "memory");
#pragma unroll
    for (int r = 0; r < 16; ++r) rli[r] = __builtin_amdgcn_rcpf(ws[crow(r, hi)]);
}
}

constexpr size_t MiB = 1u << 20;
constexpr size_t WS_CTL = 0, CTL_ZERO_BYTES = 1 * MiB;
constexpr size_t WS_MISC = 1 * MiB;
constexpr size_t WS_ROPEP = 2 * MiB;
constexpr size_t WS_ROPEC = 4 * MiB;
constexpr size_t WS_CQSSQ = 8 * MiB, WS_CKVSSQ = 8 * MiB + 512 * 1024;
constexpr size_t WS_W = 10 * MiB, W_LAYER = 28 * MiB;
constexpr size_t W_IN = 0, W_OUT = 5632 * 1024, W_MQ = 7680 * 1024, W_MKV = 8 * MiB, W_MO = 9 * MiB, W_GU = 9728 * 1024, W_DN = 20992 * 1024, W_QUP = 26 * MiB, W_KVUP = 26 * MiB + 256 * 1024;
constexpr size_t WS_MEMN = 66 * MiB;
constexpr size_t WS_MKV = 74 * MiB;
constexpr size_t WS_XB = 82 * MiB;
constexpr size_t WS_RS = 9 * MiB;
constexpr size_t WS_MIX = 146 * MiB;
constexpr size_t WS_R2 = 210 * MiB;
constexpr size_t WS_R1 = 274 * MiB;
constexpr size_t WS_STASH = 450 * MiB;
constexpr size_t WS_END = 482 * MiB;
static_assert(W_OUT == (size_t)2816 * 1024 * 2 && W_GU + (size_t)5632 * 1024 * 2 == W_DN && W_DN + (size_t)1024 * 2816 * 2 <= W_QUP && W_KVUP + 512 * 128 * 2 <= W_LAYER, "weight map");

struct Args { const void* in[18]; float* out; unsigned char* ws; int ph_lo, ph_hi; };
struct Frame {
    LAS unsigned char* lds;
    int tid, lane, wave, vcu, G, abl;
    const __attribute__((address_space(4))) Args* a;
#define FIN(name, i, T) __device__ __forceinline__ const T* name() const { return (const T*)a->in[i]; }
    FIN(x, 0, float) FIN(mem, 1, float) FIN(pos, 2, int) FIN(gains, 3, float) FIN(w_in, 4, float) FIN(w_out, 5, float) FIN(dlam, 6, float) FIN(subln, 7, float)
    FIN(qnorm, 8, float) FIN(kvnorm, 9, float) FIN(w_qup, 10, float) FIN(w_kvup, 11, float) FIN(w_mq, 12, float) FIN(w_mkv, 13, float) FIN(w_mo, 14, float)
    FIN(w_gate, 15, float) FIN(w_up, 16, float) FIN(w_down, 17, float)
#undef FIN
    __device__ __forceinline__ float* out() const { return a->out; }
    __device__ __forceinline__ unsigned char* ws() const { return a->ws; }
#define FWS(name, off, T) __device__ __forceinline__ T* name() const { return (T*)(a->ws + (off)); }
    FWS(misc, WS_MISC, float) FWS(ropeP, WS_ROPEP, float) FWS(ropeC, WS_ROPEC, float) FWS(cqssq, WS_CQSSQ, float) FWS(ckvssq, WS_CKVSSQ, float) FWS(stash, WS_STASH, float)
    FWS(XB, WS_XB, bf16_t) FWS(RS, WS_RS, float) FWS(MEMN, WS_MEMN, bf16_t) FWS(MKV, WS_MKV, bf16_t) FWS(MIX, WS_MIX, bf16_t) FWS(QC, WS_R2, bf16_t) FWS(KVC, WS_R2 + 32 * MiB, bf16_t) FWS(BR, WS_R2, bf16_t)
    FWS(QKV, WS_R1, bf16_t) FWS(H, WS_R1, bf16_t) FWS(MQ, WS_R1, bf16_t) FWS(MO, WS_R1 + 16 * MiB, bf16_t)
#undef FWS
};
__device__ __forceinline__ bf16_t* wptr(const Frame& F, int l, size_t off) { return (bf16_t*)(F.ws() + WS_W + (size_t)l * W_LAYER + off); }
__device__ __forceinline__ float wave_sum(float v) {
#pragma unroll
    for (int o = 1; o < 64; o <<= 1) v += __shfl_xor(v, o);
    return v;
}
__device__ __forceinline__ float bf2f(unsigned short u) { return __uint_as_float((unsigned)u << 16); }
typedef float f32x4_t __attribute__((ext_vector_type(4)));
typedef unsigned u32x2_t __attribute__((ext_vector_type(2)));

__device__ __forceinline__ void unit_A(const Frame& F, int l, int b, int h, int qb) {
    using namespace att;
    const int wid = F.wave, lane = F.lane, r32 = lane & 31, hi = lane >> 5;
    const int row0 = b * SEQ + qb * 256 + wid * 32;
    const bf16_t* kbase = F.QKV() + (size_t)(b * SEQ) * QKV_LD;
    float* stash = F.stash() + ((size_t)(blockIdx.x * NWAVES + wid) * 64) * 64 + lane;
    LAS float* ws = (LAS float*)(F.lds + PassLay<64, 0, 128>::WS_OFF) + wid * 64;
    f32x16 o[4]; float lsum; float rli[16];
#pragma unroll 1
    for (int map = 0; map < 2; ++map) {
        attn_pass<64, 0, 128>(F.QKV() + (size_t)(row0 + r32) * QKV_LD + h * 128 + map * 64, kbase + 512 + h * 128 + map * 64, QKV_LD, nullptr, 0,
                              kbase + 1024 + h * 128, QKV_LD, SEQ / 64, F.lds, o, lsum);
        row_recip(lsum, ws, r32, hi, rli);
        if (map == 0) {
#pragma unroll
            for (int d = 0; d < 4; ++d) { float* sp = stash + d * 1024; asm volatile("" : "+v"(sp));
#pragma unroll
                for (int r = 0; r < 16; ++r) sp[r * 64] = o[d][r] * rli[r]; }
        } else {
            const float lam = F.misc()[l], oml = F.misc()[2 + l];
#pragma unroll
            for (int d = 0; d < 4; ++d) { const float* sp = stash + d * 1024; asm volatile("" : "+v"(sp));
#pragma unroll
                for (int r = 0; r < 16; ++r) o[d][r] = sp[r * 64] - lam * (o[d][r] * rli[r]); }
            float gn[4];
#pragma unroll
            for (int d = 0; d < 4; ++d) gn[d] = F.subln()[l * 128 + d * 32 + r32] * oml;
            bf16_t* mixb = F.MIX() + (size_t)(row0 + 4 * hi) * DM + h * 128 + r32;
#pragma unroll
            for (int r = 0; r < 16; ++r) {
                float s = (o[0][r] * o[0][r] + o[1][r] * o[1][r]) + (o[2][r] * o[2][r] + o[3][r] * o[3][r]);
                s += __shfl_xor(s, 1); s += __shfl_xor(s, 2); s += __shfl_xor(s, 4); s += __shfl_xor(s, 8); s += __shfl_xor(s, 16);
                const float rstd = 1.0f / sqrtf(s * (1.0f / 128.0f) + NORM_EPS);
                bf16_t* dst = mixb + (size_t)((r & 3) + 8 * (r >> 2)) * DM; asm volatile("" : "+v"(dst));
#pragma unroll
                for (int d = 0; d < 4; ++d) dst[d * 32] = f2bf(o[d][r] * rstd * gn[d]);
            }
        }
    }
}
__device__ __forceinline__ void unit_C(const Frame& F, int b, int h, int qb) {
    using namespace att;
    const int wid = F.wave, lane = F.lane, r32 = lane & 31, hi = lane >> 5;
    const int row0 = b * SEQ + qb * 256 + wid * 32;
    LAS float* ws = (LAS float*)(F.lds + PassLay<64, 32, 64>::WS_OFF) + wid * 64;
    f32x16 o[2]; float lsum; float rli[16];
    const bf16_t* kvb = F.KVC() + (size_t)(b * SEQ) * 512 + h * 128;
    attn_pass<64, 32, 64>(F.QC() + (size_t)(row0 + r32) * 512 + h * 96, kvb, 512, F.QKV() + (size_t)(b * SEQ) * QKV_LD + 2688, QKV_LD, kvb + 64, 512, SEQ / 64, F.lds, o, lsum);
    row_recip(lsum, ws, r32, hi, rli);
    bf16_t* outb = F.MIX() + (size_t)(row0 + 4 * hi) * DM + 768 + h * 64 + r32;
#pragma unroll
    for (int r = 0; r < 16; ++r) { bf16_t* dst = outb + (size_t)((r & 3) + 8 * (r >> 2)) * DM; asm volatile("" : "+v"(dst));
#pragma unroll
        for (int d = 0; d < 2; ++d) dst[d * 32] = f2bf(o[d][r] * rli[r]); }
}
__device__ __forceinline__ void unit_M(const Frame& F, int l, int b, int h, int qb) {
    using namespace att;
    const int wid = F.wave, lane = F.lane, r32 = lane & 31, hi = lane >> 5;
    const int row0 = b * SEQ + qb * 256 + wid * 32;
    LAS float* ws = (LAS float*)(F.lds + PassLay<64, 0, 64>::WS_OFF) + wid * 64;
    f32x16 o[2]; float lsum; float rli[16];
    const bf16_t* kvb = F.MKV() + (size_t)l * MEMTOK * 512 + (size_t)(b * MEML) * 512 + h * 64;
    attn_pass<64, 0, 64>(F.MQ() + (size_t)(row0 + r32) * 256 + h * 64, kvb, 512, nullptr, 0, kvb + 256, 512, MEML / 64, F.lds, o, lsum);
    row_recip(lsum, ws, r32, hi, rli);
    bf16_t* outb = F.MO() + (size_t)(row0 + 4 * hi) * 256 + h * 64 + r32;
#pragma unroll
    for (int r = 0; r < 16; ++r) { bf16_t* dst = outb + (size_t)((r & 3) + 8 * (r >> 2)) * 256; asm volatile("" : "+v"(dst));
#pragma unroll
        for (int d = 0; d < 2; ++d) dst[d * 32] = f2bf(o[d][r] * rli[r]); }
}
constexpr int DIL_NT = 15;
__device__ __forceinline__ void dil_tile(int ti, int a, int r8, int& kb0, int& stride, int& lim, int& cls) {
    if (ti < 3) { const int t = (ti == 0) ? 1 : (ti == 1 ? 0 : 2); kb0 = 256 * a - 256 + 256 * t + (r8 & 3); stride = 4; lim = 256; cls = -1; }
    else if (ti < 9) { const int t = ti - 3; kb0 = 256 * a - 64 + 64 * t; stride = 1; lim = 64; cls = -1; }
    else { const int c = (ti - 9) / 3, t = (ti - 9) % 3; kb0 = 256 * a - 1024 + 1024 * t + 8 * c + r8; stride = 16; lim = 1024; cls = c; }
}
__device__ __forceinline__ int clampi(int v, int lo, int hi) { return v < lo ? lo : (v > hi ? hi : v); }
#define DIL_LOADK(KF, ti_) do { int kb0_, st_, lim_, cls_; dil_tile((ti_) < DIL_NT ? (ti_) : DIL_NT - 1, a, r8, kb0_, st_, lim_, cls_); \
        const bf16_t* kp0_ = base + (size_t)clampi(kb0_ + st_ * r32, 0, SEQ - 1) * QKV_LD + 1792 + h * 64 + hi * 8; \
        const bf16_t* kp1_ = base + (size_t)clampi(kb0_ + st_ * (32 + r32), 0, SEQ - 1) * QKV_LD + 1792 + h * 64 + hi * 8; \
        _Pragma("unroll") for (int d0 = 0; d0 < 4; ++d0) { KF[d0] = *(const bf16x8*)(kp0_ + d0 * 16); KF[4 + d0] = *(const bf16x8*)(kp1_ + d0 * 16); } } while (0)
#define DIL_STEP(KF, KN, ti_) do { int kb0, stride, lim, cls; dil_tile((ti_), a, r8, kb0, stride, lim, cls); \
        DIL_LOADK(KN, (ti_) + 1); \
        if (!(kb0 + 63 * stride < 0 || kb0 >= SEQ)) { \
        bf16x8 VF[8]; \
        _Pragma("unroll") for (int i = 0; i < 8; ++i) VF[i] = *(const bf16x8*)(base + (size_t)clampi(kb0 + stride * (8 * i + (lane >> 3)), 0, SEQ - 1) * QKV_LD + 2048 + h * 64 + (lane & 7) * 8); \
        f32x16 p0 = f32x16{}, p1 = f32x16{}; \
        _Pragma("unroll") for (int d0 = 0; d0 < 4; ++d0) { p0 = __builtin_amdgcn_mfma_f32_32x32x16_bf16(KF[d0], qr[d0], p0, 0, 0, 0); p1 = __builtin_amdgcn_mfma_f32_32x32x16_bf16(KF[4 + d0], qr[d0], p1, 0, 0, 0); } \
        const bool clsok = (cls < 0) || ((r32 & 1) == cls); \
        const int lo = clsok ? (pq - lim < 0 ? 0 : pq - lim) : 0x40000000; const int hib = (pq + lim > SEQ - 1) ? SEQ - 1 : pq + lim; \
        const unsigned range = clsok ? (unsigned)(hib - lo) : 0u; \
        unsigned eb = (unsigned)(kb0 + 4 * hi * stride - lo); const unsigned s32_ = 32u * (unsigned)stride; \
        _Pragma("unroll") for (int r = 0; r < 16; ++r) { const unsigned ea = eb + (unsigned)stride * (unsigned)((r & 3) + 8 * (r >> 2)); \
            p0[r] = (ea <= range) ? p0[r] : -1e30f; p1[r] = (ea + s32_ <= range) ? p1[r] : -1e30f; } \
        const float pmax = rowmax32(p0, p1); const float mn = fmaxf(m_reg, pmax), alpha = __builtin_amdgcn_exp2f(m_reg - mn); m_reg = mn; \
        float ps = 0.f; \
        _Pragma("unroll") for (int r = 0; r < 16; ++r) { p0[r] = __builtin_amdgcn_exp2f(p0[r] - mn); p1[r] = __builtin_amdgcn_exp2f(p1[r] - mn); ps += p0[r] + p1[r]; } \
        { auto rr = __builtin_amdgcn_permlane32_swap(__float_as_uint(ps), __float_as_uint(ps), false, false); ps = __uint_as_float(rr[0]) + __uint_as_float(rr[1]); } \
        l_reg = l_reg * alpha + ps; \
        bf16x8 pa0, pa1, pa2, pa3; ATT_PK4(p0, 0, pa0); ATT_PK4(p0, 8, pa1); ATT_PK4(p1, 0, pa2); ATT_PK4(p1, 8, pa3); \
        _Pragma("unroll") for (int i = 0; i < 8; ++i) *(LAS bf16x8*)(vl + v_st<2>(8 * i + (lane >> 3), (lane & 7) * 8)) = VF[i]; \
        if (__any(alpha < 1.f)) { if (hi == 0) ws[32 + r32] = alpha; asm volatile("s_waitcnt lgkmcnt(0)" ::: "memory"); \
            _Pragma("unroll") for (int d = 0; d < 2; ++d) _Pragma("unroll") for (int r = 0; r < 16; ++r) o[d][r] *= ws[32 + crow(r, hi)]; } \
        asm volatile("s_waitcnt lgkmcnt(0)" ::: "memory"); \
        pv_all<2>(o, vb, pa0, pa1, pa2, pa3); } } while (0)
__device__ __forceinline__ void dil_unit(const Frame& F, int b, int h, int r8, int a) {
    using namespace att;
    const int wid = F.wave, lane = F.lane, r32 = lane & 31, hi = lane >> 5;
    LAS unsigned char* vl = F.lds + wid * 8192;
    LAS float* ws = (LAS float*)(F.lds + 65536) + wid * 64;
    const unsigned vb = (unsigned)(uintptr_t)vl + (unsigned)v_rd_base(lane);
    const bf16_t* base = F.QKV() + (size_t)(b * SEQ) * QKV_LD;
    const int pq = 256 * a + 8 * r32 + r8;
    bf16x8 qr[4];
#pragma unroll
    for (int d0 = 0; d0 < 4; ++d0) qr[d0] = *(const bf16x8*)(base + (size_t)pq * QKV_LD + 1536 + h * 64 + d0 * 16 + hi * 8);
    float m_reg = -1e30f, l_reg = 0.f; f32x16 o[2]; o[0] = f32x16{}; o[1] = f32x16{};
    bf16x8 kA[8], kB[8];
    DIL_LOADK(kA, 0);
#pragma unroll 1
    for (int ti = 0; ti < DIL_NT; ti += 2) {
        DIL_STEP(kA, kB, ti);
        if (ti + 1 < DIL_NT) DIL_STEP(kB, kA, ti + 1);
    }
    float rli[16];
    row_recip(l_reg, ws, r32, hi, rli);
    bf16_t* outb = F.MIX() + (size_t)(b * SEQ + 256 * a + 32 * hi + r8) * DM + 512 + h * 64 + r32;
#pragma unroll
    for (int r = 0; r < 16; ++r) { bf16_t* dst = outb + (size_t)(8 * ((r & 3) + 8 * (r >> 2))) * DM; asm volatile("" : "+v"(dst));
#pragma unroll
        for (int d = 0; d < 2; ++d) dst[d * 32] = f2bf(o[d][r] * rli[r]); }
}
#undef DIL_LOADK
#undef DIL_STEP

__device__ __forceinline__ void row_pass(const Frame& F, const bf16_t* xb_in, const bf16_t* br, const float* g, bf16_t* xb_out, float* rs_out, float* fout) {
    const int gw = blockIdx.x * NWAVES + F.wave, NGW = F.G * NWAVES, lane = F.lane;
    f32x4_t gv[4];
#pragma unroll
    for (int j = 0; j < 4; ++j) gv[j] = *(const f32x4_t*)(g + 256 * j + 4 * lane);
    for (int m = gw; m < MTOK; m += NGW) {
        f32x4_t bv[4], xv[4]; float s = 0.f;
#pragma unroll
        for (int j = 0; j < 4; ++j) { const u32x2_t w = *(const u32x2_t*)(br + (size_t)m * DM + 256 * j + 4 * lane), xw = *(const u32x2_t*)(xb_in + (size_t)m * DM + 256 * j + 4 * lane);
            bv[j][0] = __uint_as_float(w.x << 16); bv[j][1] = __uint_as_float(w.x & 0xffff0000u); bv[j][2] = __uint_as_float(w.y << 16); bv[j][3] = __uint_as_float(w.y & 0xffff0000u);
            xv[j][0] = __uint_as_float(xw.x << 16); xv[j][1] = __uint_as_float(xw.x & 0xffff0000u); xv[j][2] = __uint_as_float(xw.y << 16); xv[j][3] = __uint_as_float(xw.y & 0xffff0000u);
            s += (bv[j][0] * bv[j][0] + bv[j][1] * bv[j][1]) + (bv[j][2] * bv[j][2] + bv[j][3] * bv[j][3]); }
        const float rb = 1.0f / sqrtf(wave_sum(s) * (1.0f / DM) + NORM_EPS);
#pragma unroll
        for (int j = 0; j < 4; ++j) xv[j] = xv[j] + bv[j] * rb * gv[j];
        if (fout) {
#pragma unroll
            for (int j = 0; j < 4; ++j) *(f32x4_t*)(fout + (size_t)m * DM + 256 * j + 4 * lane) = xv[j];
        } else {
            float s2 = 0.f;
#pragma unroll
            for (int j = 0; j < 4; ++j) { u32x2_t w; w.x = pg8::cvt_pk_bf16(xv[j][0], xv[j][1]); w.y = pg8::cvt_pk_bf16(xv[j][2], xv[j][3]);
                *(u32x2_t*)(xb_out + (size_t)m * DM + 256 * j + 4 * lane) = w;
                const float a0 = __uint_as_float(w.x << 16), a1 = __uint_as_float(w.x & 0xffff0000u), a2 = __uint_as_float(w.y << 16), a3 = __uint_as_float(w.y & 0xffff0000u);
                s2 += (a0 * a0 + a1 * a1) + (a2 * a2 + a3 * a3); }
            const float rx = 1.0f / sqrtf(wave_sum(s2) * (1.0f / DM) + NORM_EPS);
            if (lane == 0) rs_out[m] = rx;
        }
    }
}
__device__ __forceinline__ void norm_row(const float* src, bf16_t* dst, int lane) {
    f32x4_t v[4]; float s = 0.f;
#pragma unroll
    for (int j = 0; j < 4; ++j) { v[j] = *(const f32x4_t*)(src + 256 * j + 4 * lane); s += (v[j][0] * v[j][0] + v[j][1] * v[j][1]) + (v[j][2] * v[j][2] + v[j][3] * v[j][3]); }
    const float r = 1.0f / sqrtf(wave_sum(s) * (1.0f / DM) + NORM_EPS);
#pragma unroll
    for (int j = 0; j < 4; ++j) { u32x2_t w; w.x = pg8::cvt_pk_bf16(v[j][0] * r, v[j][1] * r); w.y = pg8::cvt_pk_bf16(v[j][2] * r, v[j][3] * r);
        *(u32x2_t*)(dst + 256 * j + 4 * lane) = w; }
}

__constant__ float ROPE_INV[24] = {1.000000000e+00f, 1.939227447e-01f, 3.760603093e-02f, 7.292664737e-03f, 1.414213562e-03f, 2.742481757e-04f, 5.318295897e-05f, 1.031338538e-05f, 1.000000000e+00f, 4.403666027e-01f, 1.939227447e-01f, 8.539710029e-02f, 3.760603093e-02f, 1.656044008e-02f, 7.292664737e-03f, 3.211445995e-03f, 1.414213562e-03f, 6.227724219e-04f, 2.742481757e-04f, 1.207697374e-04f, 5.318295897e-05f, 2.341999896e-05f, 1.031338538e-05f, 4.541670481e-06f};
__device__ __forceinline__ void cast_row(const float* src, bf16_t* dst, float* rs, int lane) {
    float s = 0.f;
#pragma unroll
    for (int j = 0; j < 4; ++j) { const f32x4_t v = *(const f32x4_t*)(src + 256 * j + 4 * lane); s += (v[0] * v[0] + v[1] * v[1]) + (v[2] * v[2] + v[3] * v[3]);
        u32x2_t w; w.x = pg8::cvt_pk_bf16(v[0], v[1]); w.y = pg8::cvt_pk_bf16(v[2], v[3]); *(u32x2_t*)(dst + 256 * j + 4 * lane) = w; }
    const float r = 1.0f / sqrtf(wave_sum(s) * (1.0f / DM) + NORM_EPS);
    if (lane == 0) *rs = r;
}
__device__ __forceinline__ int orig16(int p) { return (p & 3) | ((p & 4) << 1) | ((p & 8) >> 1); }
__device__ __forceinline__ int origkr(int p) { return (p & 3) + 4 * (p >> 3) + 16 * ((p >> 2) & 1); }
constexpr int N_WKINDS = 9;
__device__ __forceinline__ int witems(int kind) {
    return kind == 0 ? 16 * 88 : kind == 1 ? 16 * 32 : kind == 2 ? 16 * 8 : kind == 3 ? 16 * 16 : kind == 4 ? 4 * 32 : kind == 5 ? 16 * 176 : kind == 6 ? 44 * 32 : kind == 7 ? 4 * 16 : 2 * 16;
}
__device__ __forceinline__ void wmap(int kind, int n, int& src, float& scale, bool& second) {
    src = n; scale = 1.f; second = false;
    if (kind == 0) {
        if (n >= DIN) { src = -1; return; }
        const bool qsec = (n < 512) || (n >= 1536 && n < 1792);
        const bool ropesec = (n < 1024) || (n >= 1536 && n < 2048);
        if (qsec) scale = 0.125f * LOG2E;
        if (ropesec && (n & 63) < 16) src = (n & ~15) | orig16(n & 15);
        if (n >= 2688) src = 2688 + origkr(n - 2688);
    } else if (kind == 2) { scale = 0.125f * LOG2E; }
    else if (kind == 5) { const int t = n >> 8, bj = (n >> 7) & 1, j = n & 127; src = t * 128 + j; second = (bj != 0); }
    else if (kind == 7) {
        if (n >= 384) { src = -1; return; }
        const int h = n / 96, w = n - 96 * h; src = 96 * h + (w < 64 ? w : 64 + origkr(w - 64)); scale = 0.10206207261596575f * LOG2E;
    }
}
__device__ __forceinline__ void prep_item(const Frame& F, int l, int kind, int item, LAS float* scr, int lane) {
    const float* g = F.gains() + (size_t)l * 7 * DM;
    const float* W; const float* W2 = nullptr; const float* gain = nullptr; bf16_t* dst; int K, Nsrc, Ndst;
    if (kind == 0)      { W = F.w_in() + (size_t)l * DM * DIN; gain = g; dst = wptr(F, l, W_IN); K = DM; Nsrc = DIN; Ndst = QKV_LD; }
    else if (kind == 1) { W = F.w_out() + (size_t)l * DM * DM; dst = wptr(F, l, W_OUT); K = DM; Nsrc = DM; Ndst = DM; }
    else if (kind == 2) { W = F.w_mq() + (size_t)l * DM * 256; gain = g + 2 * DM; dst = wptr(F, l, W_MQ); K = DM; Nsrc = 256; Ndst = 256; }
    else if (kind == 3) { W = F.w_mkv() + (size_t)l * DM * 512; gain = g + 3 * DM; dst = wptr(F, l, W_MKV); K = DM; Nsrc = 512; Ndst = 512; }
    else if (kind == 4) { W = F.w_mo() + (size_t)l * 256 * DM; dst = wptr(F, l, W_MO); K = 256; Nsrc = DM; Ndst = DM; }
    else if (kind == 5) { W = F.w_gate() + (size_t)l * DM * DFF; W2 = F.w_up() + (size_t)l * DM * DFF; gain = g + 5 * DM; dst = wptr(F, l, W_GU); K = DM; Nsrc = DFF; Ndst = 2 * DFF; }
    else if (kind == 6) { W = F.w_down() + (size_t)l * DFF * DM; dst = wptr(F, l, W_DN); K = DFF; Nsrc = DM; Ndst = DM; }
    else if (kind == 7) { W = F.w_qup() + (size_t)l * 256 * 384; gain = F.qnorm() + l * 256; dst = wptr(F, l, W_QUP); K = 256; Nsrc = 384; Ndst = 512; }
    else                { W = F.w_kvup() + (size_t)l * 128 * 512; gain = F.kvnorm() + l * 128; dst = wptr(F, l, W_KVUP); K = 128; Nsrc = 512; Ndst = 512; }
    const int nblk = Ndst / 32, kb = item / nblk, nb = item % nblk, k0 = 64 * kb, n0 = 32 * nb;
    int src; float scale; bool second; wmap(kind, n0 + (lane & 31), src, scale, second);
    if (second) W = W2;
#pragma unroll 8
    for (int i = 0; i < 32; ++i) { const int kk = 2 * i + (lane >> 5); float v = 0.f;
        if (src >= 0) { v = W[(size_t)(k0 + kk) * Nsrc + src] * scale; if (gain) v *= gain[k0 + kk]; }
        scr[kk * 33 + (lane & 31)] = v; }
    asm volatile("s_waitcnt lgkmcnt(0)" ::: "memory");
    const int c = lane & 7;
#pragma unroll
    for (int j = 0; j < 4; ++j) { const int n = (lane >> 3) + 8 * j; const LAS float* s = scr + (8 * c) * 33 + n;
        pg8::u32x4 o4; o4.x = pg8::cvt_pk_bf16(s[0 * 33], s[1 * 33]); o4.y = pg8::cvt_pk_bf16(s[2 * 33], s[3 * 33]); o4.z = pg8::cvt_pk_bf16(s[4 * 33], s[5 * 33]); o4.w = pg8::cvt_pk_bf16(s[6 * 33], s[7 * 33]);
        *(pg8::u32x4*)(dst + (size_t)(n0 + n) * K + k0 + 8 * c) = o4; }
    asm volatile("s_waitcnt lgkmcnt(0)" ::: "memory");
}
__device__ __forceinline__ void prologue(const Frame& F) {
    LAS float* scr = (LAS float*)(F.lds + F.wave * 16384);
    const int gw = blockIdx.x * NWAVES + F.wave, NGW = F.G * NWAVES;
    int per_layer = 0;
#pragma unroll
    for (int k = 0; k < N_WKINDS; ++k) per_layer += witems(k);
    for (int it = gw; it < 2 * per_layer; it += NGW) {
        const int l = it / per_layer; int r = it - l * per_layer, kind = 0;
        while (r >= witems(kind)) { r -= witems(kind); ++kind; }
        prep_item(F, l, kind, r, scr, F.lane);
    }
    for (int m = gw; m < MTOK; m += NGW) cast_row(F.x() + (size_t)m * DM, F.XB() + (size_t)m * DM, F.RS() + m, F.lane);
    for (int m = gw; m < MEMTOK; m += NGW) norm_row(F.mem() + (size_t)m * DM, F.MEMN() + (size_t)m * DM, F.lane);
    const int gt = blockIdx.x * (NWAVES * 64) + F.tid, NGT = F.G * NWAVES * 64;
    for (int i = gt; i < MTOK * 24; i += NGT) {
        const int row = i / 24, f = i - row * 24;
        const float p = (float)F.pos()[row];
        const float inv = ROPE_INV[f];
        const float ang = p * inv;
        const double t = (double)ang * 0.15915494309189535; const float fr = (float)(t - rint(t));
        const float cs = __builtin_amdgcn_cosf(fr), sn = __builtin_amdgcn_sinf(fr);
        if (f < 8) { F.ropeP()[(size_t)row * 16 + f] = cs; F.ropeP()[(size_t)row * 16 + 8 + f] = sn; }
        else { const int ff = f - 8; F.ropeC()[(size_t)row * 32 + ff] = cs; F.ropeC()[(size_t)row * 32 + 16 + ff] = sn; }
    }
    if (blockIdx.x == 0 && F.tid < 2) {
        const int l = F.tid; const float* lv = F.dlam() + l * 4 * 64; float s01 = 0.f, s23 = 0.f;
        for (int i = 0; i < 64; ++i) { s01 += lv[i] * lv[64 + i]; s23 += lv[128 + i] * lv[192 + i]; }
        const float lam_init = 0.8f - 0.6f * expf(-0.3f * (float)l);
        F.misc()[l] = expf(s01) - expf(s23) + lam_init; F.misc()[2 + l] = 1.0f - lam_init;
    }
}

constexpr int N_PHASES = 3 + 12 * DEPTH;
constexpr int ATT_LDS_MAX = att::PassLay<64, 0, 128>::TOTAL;
static_assert(ATT_LDS_MAX <= 131072 && att::PassLay<64, 32, 64>::TOTAL <= 131072, "attention LDS");

__global__ void __launch_bounds__(NWAVES * 64, 2) mk_fwd(Args args) {
    extern __shared__ __attribute__((aligned(16))) unsigned char lds_raw[];
    cg::grid_group grid = cg::this_grid();
    Frame F;
    F.lds = (LAS unsigned char*)lds_raw;
    F.tid = threadIdx.x; F.lane = F.tid & 63; F.wave = __builtin_amdgcn_readfirstlane(F.tid >> 6);
    F.abl = 0; F.G = gridDim.x; { const int bx = blockIdx.x; F.vcu = (F.G % 8 == 0) ? (bx % 8) * (F.G / 8) + bx / 8 : bx; }
    const __attribute__((address_space(4))) Args* ap = (const __attribute__((address_space(4))) Args*)__builtin_amdgcn_kernarg_segment_ptr();
    F.a = ap;
    unsigned char* ws = F.ws();

    volatile LAS unsigned* misc_lds = (volatile LAS unsigned*)(F.lds + 131072);
    for (int u = F.tid; u < 64; u += NWAVES * 64) misc_lds[u] = 0u;
    __syncthreads();
    XcdBarrier bar = xcd_barrier_post((unsigned*)(ws + WS_CTL) + 4096, misc_lds + 8);

    if (args.ph_lo < 0) grid.sync();
    int ph = args.ph_lo, rep = 0;
    while (ph < args.ph_hi) {
        { int t_ = threadIdx.x; asm volatile("" : "+v"(t_)); F.tid = t_; F.lane = t_ & 63; F.wave = __builtin_amdgcn_readfirstlane(t_ >> 6); const __attribute__((address_space(4))) Args* a_ = ap; asm volatile("" : "+s"(a_)); F.a = a_; }
        int l = 0, k = -1;
        if (ph == 0) k = -1; else if (ph <= 2) { k = -2; l = ph - 1; } else { l = (ph - 3) / 12; k = (ph - 3) % 12; }
#ifndef PROBE_MASK
#define PROBE_MASK 0
#endif
        const int nrep = (k >= 0 && ((PROBE_MASK >> k) & 1)) ? 2 : 1;
        if (k == -1) {
#ifndef NO_PRO
            prologue(F);
#endif
        } else if (k == -2 || k == 3 || k == 5 || k == 7 || k == 10) {
            pg8::Gemm g; pg8::EpiPlain E; int c = (int)blockIdx.x;
            if (k == -2) { g = pg8::Gemm{F.MEMN(), wptr(F, l, W_MKV), MEMTOK, 512, DM, DM}; E = pg8::EpiPlain{F.MKV() + (size_t)l * MEMTOK * 512, 512, nullptr}; c = (c + 128 * l) % F.G; }
            else if (k == 3) { g = pg8::Gemm{F.MIX(), wptr(F, l, W_OUT), MTOK, DM, DM, DM}; E = pg8::EpiPlain{F.BR(), DM, nullptr}; }
            else if (k == 5) { g = pg8::Gemm{F.XB(), wptr(F, l, W_MQ), MTOK, 256, DM, DM}; E = pg8::EpiPlain{F.MQ(), 256, F.RS()}; }
            else if (k == 7) { g = pg8::Gemm{F.MO(), wptr(F, l, W_MO), MTOK, DM, 256, 256}; E = pg8::EpiPlain{F.BR(), DM, nullptr}; }
            else { g = pg8::Gemm{F.H(), wptr(F, l, W_DN), MTOK, DM, DFF, DFF}; E = pg8::EpiPlain{F.BR(), DM, nullptr}; }
            pg8::StaticOrder S; S.init(g.M, g.N, F.G, c);
#ifndef NO_PLAIN
            pg8::gemm_phase<pg8::EpiPlain, pg8::StaticOrder, true, true>(F.lds, g, S, E);
#endif
        } else if (k == 0) {
            pg8::Gemm g{F.XB(), wptr(F, l, W_IN), MTOK, QKV_LD, DM, DM}; pg8::StaticOrder S; S.init(MTOK, QKV_LD, F.G, (int)blockIdx.x);
            pg8::EpiQKV E{F.QKV(), F.ropeP(), F.ropeC(), F.cqssq(), F.ckvssq(), F.RS()};
#ifndef NO_QKV
            pg8::gemm_phase<pg8::EpiQKV, pg8::StaticOrder, true, true>(F.lds, g, S, E);
#endif
        } else if (k == 1) {
            int kq = 256, kkv = 128; asm volatile("" : "+s"(kq), "+s"(kkv));
            { pg8::Gemm g{F.QKV() + 2304, wptr(F, l, W_QUP), MTOK, 512, kq, QKV_LD}; pg8::StaticOrder S; S.init(MTOK, 512, F.G, (int)blockIdx.x);
              pg8::EpiMLA<true, 256> E{F.QC(), F.cqssq(), F.ropeC()};
#ifndef NO_MLA
              pg8::gemm_phase<pg8::EpiMLA<true, 256>, pg8::StaticOrder, true, true>(F.lds, g, S, E);
#endif
 }
            { pg8::Gemm g{F.QKV() + 2560, wptr(F, l, W_KVUP), MTOK, 512, kkv, QKV_LD}; pg8::StaticOrder S; S.init(MTOK, 512, F.G, (int)blockIdx.x);
              pg8::EpiMLA<false, 128> E{F.KVC(), F.ckvssq(), F.ropeC()};
#ifndef NO_MLA
              pg8::gemm_phase<pg8::EpiMLA<false, 128>, pg8::StaticOrder, true, true>(F.lds, g, S, E);
#endif
 }
        } else if (k == 2) {
#ifndef PROBE_SUB
#define PROBE_SUB 7
#endif
#ifndef PROBE_ABL
#define PROBE_ABL 0
#endif
            F.abl = (rep + 1 < nrep) ? PROBE_ABL : 0;
            const int sub = (rep + 1 < nrep) ? PROBE_SUB : 7;
#ifndef NO_A
            if (sub & 1) {
#pragma unroll 1
            for (int i = 0; i < 2; ++i) { const int u = 2 * F.vcu + i; unit_A(F, l, u >> 5, (u >> 3) & 3, u & 7); } }
#endif
#ifndef NO_C
            if (sub & 2) {
#pragma unroll 1
            for (int i = 0; i < 2; ++i) { const int u = 2 * F.vcu + i; unit_C(F, u >> 5, (u >> 3) & 3, u & 7); } }
#endif
            __syncthreads();
#ifndef NO_B
            if (sub & 4) {
#pragma unroll 1
            for (int i = 0; i < 2; ++i) { const int w = (F.vcu * NWAVES + F.wave) + 2048 * i; dil_unit(F, w >> 8, (w >> 6) & 3, (w >> 3) & 7, w & 7); } }
#endif
        } else if (k == 4 || k == 8 || k == 11) {
            const float* g = F.gains() + (size_t)l * 7 * DM + (k == 4 ? 1 : (k == 8 ? 4 : 6)) * DM;
#ifndef NO_ROW
            const bool last = (k == 11 && l == DEPTH - 1);
            if (rep + 1 < nrep) row_pass(F, F.XB(), F.BR(), g, F.MIX(), F.cqssq(), last ? (float*)F.QKV() : nullptr);
            else row_pass(F, F.XB(), F.BR(), g, F.XB(), F.RS(), last ? F.out() : nullptr);
#endif
        } else if (k == 6) {
#ifndef NO_M
#pragma unroll 1
            for (int i = 0; i < 2; ++i) { const int u = 2 * F.vcu + i; unit_M(F, l, u >> 5, (u >> 3) & 3, u & 7); }
#endif
        } else if (k == 9) {
            pg8::Gemm g{F.XB(), wptr(F, l, W_GU), MTOK, 2 * DFF, DM, DM}; pg8::StaticOrder S; S.init(MTOK, 2 * DFF, F.G, (int)blockIdx.x);
            pg8::EpiSwiGLU E{F.H(), F.RS()};
#ifndef NO_GU
            pg8::gemm_phase<pg8::EpiSwiGLU, pg8::StaticOrder, true, true>(F.lds, g, S, E);
#endif
        }
        if (rep + 1 < nrep) { xcd_barrier(bar); ++rep; continue; }
        if (ph + 1 < args.ph_hi && !(ph == 1 || ph == 2)) {
            xcd_barrier(bar);
        }
        ++ph; rep = 0;
    }
}

extern "C" void kernel_launch(void* const* d_in, const int* in_sizes, int n_in, void* d_out, int out_size, void* d_ws, size_t ws_size, hipStream_t stream) {
    static int grid = 0;
    if (grid == 0) {
        int dev = 0, cus = 0, per_cu = 0;
        if (n_in != 18 || in_sizes[0] != MTOK * DM || out_size != MTOK * DM || ws_size < WS_END) {
            fprintf(stderr, "kernel_launch: unexpected shapes / workspace (n_in %d, ws %zu < %zu?)\n", n_in, ws_size, (size_t)WS_END); grid = -1; return; }
        (void)hipGetDevice(&dev);
        (void)hipDeviceGetAttribute(&cus, hipDeviceAttributeMultiprocessorCount, dev);
        (void)hipFuncSetAttribute((const void*)mk_fwd, hipFuncAttributeMaxDynamicSharedMemorySize, LDS_BYTES);
        (void)hipOccupancyMaxActiveBlocksPerMultiprocessor(&per_cu, (const void*)mk_fwd, NWAVES * 64, LDS_BYTES);
        (void)hipGetLastError();
        grid = cus;
        if (per_cu < 1) fprintf(stderr, "kernel_launch: occupancy query says %d blocks per CU\n", per_cu);
    }
    if (grid < 0) return;
    (void)hipMemsetAsync((char*)d_ws + WS_CTL, 0, CTL_ZERO_BYTES, stream);
    Args a{};
    for (int i = 0; i < 18; ++i) a.in[i] = d_in[i];
    a.out = (float*)d_out; a.ws = (unsigned char*)d_ws;
#ifdef MK_SPLIT
    for (int ph = 0; ph < N_PHASES; ++ph) {
        if (ph == 1 || ph == 2) continue;
        a.ph_lo = (ph == 3) ? 1 : ph; a.ph_hi = ph + 1;
        void* kargs[] = {&a};
        hipError_t e = hipLaunchCooperativeKernel((const void*)mk_fwd, dim3(grid), dim3(NWAVES * 64), kargs, LDS_BYTES, stream);
        if (e != hipSuccess) { fprintf(stderr, "cooperative launch failed: %s (grid %d)\n", hipGetErrorString(e), grid); break; }
    }
#else
    a.ph_lo = 0; a.ph_hi = N_PHASES;
    void* kargs[] = {&a};
    hipError_t e = hipLaunchCooperativeKernel((const void*)mk_fwd, dim3(grid), dim3(NWAVES * 64), kargs, LDS_BYTES, stream);
    if (e != hipSuccess) fprintf(stderr, "cooperative launch failed: %s (grid %d)\n", hipGetErrorString(e), grid);
#endif
}
```
